# Optimizing an MI355X kernel written in HIP

```python
import jax, jax.numpy as jnp
from jax import lax
import numpy as np

D_MODEL = 2048
BATCH = 4
SEQ = 4096
DEPTH = 1

CHUNK = 64
HEAD_DIM = 64
D_MIX = D_MODEL
N_HEADS_A = (D_MIX // 2) // HEAD_DIM
N_KV_A = N_HEADS_A // 4
WINDOW = 128
N_PREV_A = WINDOW // CHUNK
N_HEADS_B = (D_MIX // 2) // HEAD_DIM
N_PREV_B = 8
REL_CLIP = 128
N_REL = 2 * REL_CLIP + 1
DA_Q = N_HEADS_A * HEAD_DIM
DA_KV = N_KV_A * HEAD_DIM
DB = N_HEADS_B * HEAD_DIM
D_IN = DA_Q + 2 * DA_KV + 3 * DB
N_GROUPS = 4
EXPERTS_PER_GROUP = 8
N_EXPERTS = N_GROUPS * EXPERTS_PER_GROUP
TOP_K_INNER = 2
D_EXPERT = D_MODEL // 4
EPS = 1e-6
NEG_INF = -1e30

kernel_name = "hybrid_chunk_swa_relbias_hiermoe"


def rms_norm(x, g):
    xf = x.astype(jnp.float32)
    y = xf * lax.rsqrt(jnp.mean(xf * xf, axis=-1, keepdims=True) + EPS)
    return (y * g.astype(jnp.float32)).astype(x.dtype)


def modulate(h, shift, scale):
    return h * (1 + scale[:, None, :]) + shift[:, None, :]


def alibi_slopes(n_heads):
    return jnp.exp2(-8.0 * jnp.arange(1, n_heads + 1, dtype=jnp.float32) / n_heads)


def chunk_band_attention(q, k, v, n_prev, bias_fn, sinks):
    b, s, hq, dh = q.shape
    hkv = k.shape[2]
    rep = hq // hkv
    n_chunks = s // CHUNK
    band = (n_prev + 1) * CHUNK
    pad = n_prev * CHUNK
    kp = jnp.pad(k, ((0, 0), (pad, 0), (0, 0), (0, 0)))
    vp = jnp.pad(v, ((0, 0), (pad, 0), (0, 0), (0, 0)))
    qc = q.reshape(b, n_chunks, CHUNK, hkv, rep, dh).transpose(1, 0, 2, 3, 4, 5)
    scale = dh ** -0.5

    def one_chunk(args):
        q_i, ci = args
        kb = lax.dynamic_slice_in_dim(kp, ci * CHUNK, band, axis=1)
        vb = lax.dynamic_slice_in_dim(vp, ci * CHUNK, band, axis=1)
        logits = jnp.einsum('bqgrd,bkgd->bgrqk', q_i, kb).astype(jnp.float32) * scale
        q_pos = ci * CHUNK + jnp.arange(CHUNK)
        k_pos = (ci - n_prev) * CHUNK + jnp.arange(band)
        rel = q_pos[:, None] - k_pos[None, :]
        logits = logits + bias_fn(rel).reshape(hkv, rep, CHUNK, band)[None]
        logits = jnp.where((k_pos >= 0)[None, None, None, None, :], logits, NEG_INF)
        m = jnp.max(logits, axis=-1, keepdims=True)
        if sinks is not None:
            sink = sinks.astype(jnp.float32).reshape(1, hkv, rep, 1, 1)
            m = jnp.maximum(m, sink)
        p = jnp.exp(logits - m)
        denom = jnp.sum(p, axis=-1, keepdims=True)
        if sinks is not None:
            denom = denom + jnp.exp(sink - m)
        probs = (p / denom).astype(v.dtype)
        return jnp.einsum('bgrqk,bkgd->bqgrd', probs, vb)

    out = lax.map(one_chunk, (qc, jnp.arange(n_chunks)))
    return out.transpose(1, 0, 2, 3, 4, 5).reshape(b, s, hq * dh)


def hier_moe(h, w_rg, b_rg, w_re, b_re, w_gate, w_up, w_down):
    t = h.reshape(-1, D_MODEL)
    n_tok = t.shape[0]
    g_logits = (t @ w_rg + b_rg).astype(jnp.float32)
    g_prob = jax.nn.softmax(g_logits, axis=-1)
    g_idx = jnp.argmax(g_logits, axis=-1)
    p_g = jnp.take_along_axis(g_prob, g_idx[:, None], axis=-1)
    e_logits = (t @ w_re + b_re).astype(jnp.float32).reshape(n_tok, N_GROUPS, EXPERTS_PER_GROUP)
    sel = jnp.take_along_axis(e_logits, g_idx[:, None, None], axis=1)[:, 0]
    top_v, top_i = lax.top_k(sel, TOP_K_INNER)
    w_sel = jax.nn.softmax(top_v, axis=-1) * p_g
    ids = g_idx[:, None] * EXPERTS_PER_GROUP + top_i
    combine = jnp.sum(jax.nn.one_hot(ids, N_EXPERTS, dtype=jnp.float32) * w_sel[..., None], axis=1)
    y = jnp.zeros((n_tok, D_MODEL), jnp.float32)
    for e in range(N_EXPERTS):
        a = jax.nn.silu(t @ w_gate[e]) * (t @ w_up[e])
        y = y + combine[:, e:e + 1] * (a @ w_down[e]).astype(jnp.float32)
    return y.astype(h.dtype).reshape(h.shape)


def setup_inputs(seed: int = 0) -> dict:
    key = jax.random.key(seed)
    ks = jax.random.split(key, 24)
    f32 = jnp.float32
    L = DEPTH

    def nrm(k, shape, s):
        return jax.random.normal(k, shape, f32) * s

    return {
        "x": nrm(ks[0], (BATCH, SEQ, D_MODEL), 1.0),
        "c": nrm(ks[1], (BATCH, D_MODEL), 1.0),
        "w_ada": nrm(ks[2], (L, D_MODEL, 6 * D_MODEL), 0.5 * D_MODEL ** -0.5),
        "b_ada": nrm(ks[3], (L, 6 * D_MODEL), 0.02),
        "g_mix": 1.0 + nrm(ks[4], (L, D_MODEL), 0.02),
        "w_in": nrm(ks[5], (L, D_MODEL, D_IN), D_MODEL ** -0.5),
        "sinks_a": nrm(ks[6], (L, N_HEADS_A), 0.5),
        "rel_bias_b": nrm(ks[7], (L, N_HEADS_B, N_REL), 0.2),
        "g_out_a": 1.0 + nrm(ks[8], (L, DA_Q), 0.02),
        "g_out_b": 1.0 + nrm(ks[9], (L, DB), 0.02),
        "w_out": nrm(ks[10], (L, D_MIX, D_MODEL), D_MIX ** -0.5),
        "g_ffn": 1.0 + nrm(ks[11], (L, D_MODEL), 0.02),
        "w_router_group": nrm(ks[12], (L, D_MODEL, N_GROUPS), D_MODEL ** -0.5),
        "b_router_group": nrm(ks[13], (L, N_GROUPS), 0.01),
        "w_router_expert": nrm(ks[14], (L, D_MODEL, N_EXPERTS), D_MODEL ** -0.5),
        "b_router_expert": nrm(ks[15], (L, N_EXPERTS), 0.01),
        "w_gate": nrm(ks[16], (L, N_EXPERTS, D_MODEL, D_EXPERT), D_MODEL ** -0.5),
        "w_up": nrm(ks[17], (L, N_EXPERTS, D_MODEL, D_EXPERT), D_MODEL ** -0.5),
        "w_down": nrm(ks[18], (L, N_EXPERTS, D_EXPERT, D_MODEL), D_EXPERT ** -0.5),
        "w_ada_final": nrm(ks[19], (D_MODEL, 2 * D_MODEL), 0.5 * D_MODEL ** -0.5),
        "b_ada_final": nrm(ks[20], (2 * D_MODEL,), 0.02),
        "g_final": 1.0 + nrm(ks[21], (D_MODEL,), 0.02),
    }


def reference(x, c, w_ada, b_ada, g_mix, w_in, sinks_a, rel_bias_b, g_out_a, g_out_b, w_out,
              g_ffn, w_router_group, b_router_group, w_router_expert, b_router_expert,
              w_gate, w_up, w_down, w_ada_final, b_ada_final, g_final):
    b, s, _ = x.shape
    c_act = jax.nn.silu(c)
    slopes = alibi_slopes(N_HEADS_A)
    for l in range(DEPTH):
        mod = c_act @ w_ada[l] + b_ada[l]
        sh1, sc1, gt1, sh2, sc2, gt2 = jnp.split(mod, 6, axis=-1)

        h = modulate(rms_norm(x, g_mix[l]), sh1, sc1)
        proj = h @ w_in[l]
        qa, ka, va, qb, kb, vb = jnp.split(
            proj, np.cumsum([DA_Q, DA_KV, DA_KV, DB, DB]).tolist(), axis=-1)
        qa = qa.reshape(b, s, N_HEADS_A, HEAD_DIM)
        ka = ka.reshape(b, s, N_KV_A, HEAD_DIM)
        va = va.reshape(b, s, N_KV_A, HEAD_DIM)
        qb = qb.reshape(b, s, N_HEADS_B, HEAD_DIM)
        kb = kb.reshape(b, s, N_HEADS_B, HEAD_DIM)
        vb = vb.reshape(b, s, N_HEADS_B, HEAD_DIM)

        def alibi_bias(rel):
            return -slopes[:, None, None] * jnp.abs(rel).astype(jnp.float32)[None]

        rb = rel_bias_b[l]

        def rel_bias(rel):
            idx = jnp.clip(rel, -REL_CLIP, REL_CLIP) + REL_CLIP
            return rb[:, idx].astype(jnp.float32)

        o_a = chunk_band_attention(qa, ka, va, N_PREV_A, alibi_bias, sinks_a[l])
        o_b = chunk_band_attention(qb, kb, vb, N_PREV_B, rel_bias, None)
        o = jnp.concatenate([rms_norm(o_a, g_out_a[l]), rms_norm(o_b, g_out_b[l])], axis=-1)
        x = x + gt1[:, None, :] * (o @ w_out[l])

        h = modulate(rms_norm(x, g_ffn[l]), sh2, sc2)
        y = hier_moe(h, w_router_group[l], b_router_group[l], w_router_expert[l],
                     b_router_expert[l], w_gate[l], w_up[l], w_down[l])
        x = x + gt2[:, None, :] * y

    modf = c_act @ w_ada_final + b_ada_final
    shf, scf = jnp.split(modf, 2, axis=-1)
    return modulate(rms_norm(x, g_final), shf, scf)
```

```cpp
#include <hip/hip_runtime.h>
#include <cstdio>
#include <cstdint>

#ifndef MK_PER_PHASE
#define MK_PER_PHASE 0
#endif

#ifndef PROBE_EXTRA_PHASE
#define PROBE_EXTRA_PHASE -1
#endif
#ifndef EPI_REPS
#define EPI_REPS 1
#endif
#ifndef REPEAT_MASK
#define REPEAT_MASK 0
#endif
#define GAS __attribute__((address_space(1)))
#define LAS __attribute__((address_space(3)))
typedef unsigned short bf16;
typedef short bf16x8 __attribute__((ext_vector_type(8)));
typedef short s16x4 __attribute__((ext_vector_type(4)));
typedef float f32x4 __attribute__((ext_vector_type(4)));
typedef float f32x16 __attribute__((ext_vector_type(16)));
typedef unsigned u32x4 __attribute__((ext_vector_type(4)));
typedef unsigned u32x2 __attribute__((ext_vector_type(2)));
typedef float f32x2_t __attribute__((ext_vector_type(2)));
typedef __bf16 bf16x2_t __attribute__((ext_vector_type(2)));

constexpr int DM = 2048, NB = 4, SEQ = 4096, NT = NB * SEQ, DIN = 4608, NEXP = 32, DE = 512;
constexpr int COL_QA = 0, COL_KA = 1024, COL_VA = 1280, COL_QB = 1536, COL_KB = 2560, COL_VB = 3584;
constexpr int MAXTILES = 160, MAXSLOTS = MAXTILES * 256;
constexpr float EPS = 1e-6f, LOG2E = 1.4426950408889634f;

constexpr size_t MiB = 1u << 20;
constexpr size_t WS_CTL = 0, CTL_ZERO_BYTES = 16384;
constexpr size_t WS_MOD = 1 * MiB;
constexpr size_t WS_ROUTE = 2 * MiB;
constexpr size_t RT_TOKE = 0, RT_TOKW = 131072, RT_RANK = 262144, RT_SLOT = 393216, RT_CNT = 524288, RT_ROWIDX = 557056, RT_TILEEXP = 720896, RT_NTILES = 724992, RT_TSTART = 729088;
constexpr size_t WS_AUX = 3 * MiB;
constexpr size_t WS_SSQ = 3 * MiB + 512 * 1024;
constexpr size_t WS_WRT = 4 * MiB;
constexpr size_t WS_WIN = 5 * MiB;
constexpr size_t WS_WOUT = 23 * MiB;
constexpr size_t WS_WGU = 32 * MiB;
constexpr size_t WS_WD = 160 * MiB;
constexpr size_t WS_H = 224 * MiB;
constexpr size_t WS_QKV = 288 * MiB;
constexpr size_t WS_O = 432 * MiB;
constexpr size_t WS_Y = 288 * MiB;
constexpr size_t WS_ACT = 448 * MiB;
constexpr size_t WS_X1 = 496 * MiB;
constexpr size_t WS_KVH = 560 * MiB;
constexpr size_t KVH_KA = 0, KVH_VA = 8 * MiB, KVH_KB = 16 * MiB, KVH_VB = 48 * MiB;
constexpr size_t WS_RSS = 640 * MiB;
constexpr size_t WS_END = 644 * MiB;

constexpr int RING_BYTES = 131072;
constexpr int MISC_OFF = 151552;
constexpr int LDS_BYTES = 155648;

__device__ __forceinline__ unsigned cvtpk(float lo, float hi) { f32x2_t v = {lo, hi}; bf16x2_t b = __builtin_convertvector(v, bf16x2_t); return __builtin_bit_cast(unsigned, b); }
__device__ __forceinline__ unsigned cvt4_fp8(float a, float b, float c, float d) {
    a = __builtin_fminf(__builtin_fmaxf(a, -448.f), 448.f); b = __builtin_fminf(__builtin_fmaxf(b, -448.f), 448.f);
    c = __builtin_fminf(__builtin_fmaxf(c, -448.f), 448.f); d = __builtin_fminf(__builtin_fmaxf(d, -448.f), 448.f);
    int r = 0; r = __builtin_amdgcn_cvt_pk_fp8_f32(a, b, r, false); r = __builtin_amdgcn_cvt_pk_fp8_f32(c, d, r, true); return (unsigned)r; }
constexpr float F8_SH = 8.0f, F8_SWGU = 1024.0f, F8_SACT = 8.0f, F8_SWD = 512.0f, F8_SY = 32.0f, F8_SO = 64.0f, F8_SWO = 1024.0f;
__device__ __forceinline__ float bf_lo(unsigned u) { return __uint_as_float(u << 16); }
__device__ __forceinline__ float bf_hi(unsigned u) { return __uint_as_float(u & 0xffff0000u); }
__device__ __forceinline__ float wave_sum(float v) {
#pragma unroll
    for (int o = 1; o < 64; o <<= 1) v += __shfl_xor(v, o);
    return v;
}
#define LDS_WAIT() asm volatile("s_waitcnt lgkmcnt(0)" ::: "memory")

#define XB_TMO      128
#define XB_XCNT(j)  (256  + 64 * (j))
#define XB_XSUB(j)  (1280 + 64 * (j))
#define XB_XGEN(j)  (2304 + 64 * (j))
#define XB_TOP      3328
#define XB_TOPGEN   3392
#define XCD_BAR_WORDS 3456
#define XB_SPIN_CAP (1u << 18)

__device__ __forceinline__ unsigned xb_ld(unsigned* p)              { return __hip_atomic_load(p, __ATOMIC_RELAXED, __HIP_MEMORY_SCOPE_AGENT); }
__device__ __forceinline__ unsigned xb_add(unsigned* p, unsigned v) { return __hip_atomic_fetch_add(p, v, __ATOMIC_RELAXED, __HIP_MEMORY_SCOPE_AGENT); }
__device__ __forceinline__ unsigned xb_xcc_id() { return (unsigned)__builtin_amdgcn_s_getreg((3 << 11) | 20) & 0xFu; }
#define XB_SPIN(cond, bar) do { unsigned _sp = 0; while (cond) { __builtin_amdgcn_s_sleep(1); \
    if ((++_sp & 255u) == 0u) { if (xb_ld(&(bar)[XB_TMO])) break; if (_sp > XB_SPIN_CAP) { atomicAdd(&(bar)[XB_TMO], 1u); break; } } } } while (0)

struct XcdBarrier { unsigned* bar; unsigned x; volatile LAS unsigned* st; };

__device__ __forceinline__ XcdBarrier xcd_barrier_post(unsigned* bar, volatile LAS unsigned* st) {
    XcdBarrier b; b.bar = bar; b.x = xb_xcc_id(); b.st = st;
    if (threadIdx.x == 0) (void)xb_add(&bar[XB_XCNT(b.x)], 1u);
    return b;
}
__device__ __forceinline__ void xcd_barrier_complete(unsigned* bar, unsigned x, unsigned& nloc, unsigned& nx) {
    const unsigned G = gridDim.x * gridDim.y * gridDim.z;
    unsigned sum, cnt, mine, sp = 0u;
    for (;;) {
        sum = 0u; cnt = 0u; mine = 0u;
#pragma unroll
        for (unsigned j = 0; j < 16; ++j) { const unsigned c = xb_ld(&bar[XB_XCNT(j)]); sum += c; cnt += (c > 0u) ? 1u : 0u; mine = (j == x) ? c : mine; }
        if (sum == G) break;
        __builtin_amdgcn_s_sleep(1);
        if ((++sp & 255u) == 0u) { if (xb_ld(&bar[XB_TMO])) break; if (sp > XB_SPIN_CAP) { atomicAdd(&bar[XB_TMO], 1u); break; } }
    }
    nloc = mine > 0u ? mine : 1u; nx = cnt > 0u ? cnt : 1u;
}
__device__ __forceinline__ void xcd_barrier(const XcdBarrier& b) {
    asm volatile("s_waitcnt vmcnt(0)" ::: "memory");
    __syncthreads();
    if (threadIdx.x == 0) {
        unsigned* bar = b.bar;
        __builtin_amdgcn_s_waitcnt(0);
        unsigned nloc = b.st[0], nx = b.st[1];
        if (nloc == 0u) { xcd_barrier_complete(bar, b.x, nloc, nx); b.st[0] = nloc; b.st[1] = nx; }
        const unsigned old = xb_add(&bar[XB_XSUB(b.x)], 1u);
        const unsigned gen = old / nloc;
        if (old + 1u == (gen + 1u) * nloc) {
            __builtin_amdgcn_fence(__ATOMIC_RELEASE, "agent");
            asm volatile("s_waitcnt vmcnt(0)" ::: "memory");
            const unsigned og = xb_add(&bar[XB_TOP], 1u);
            const unsigned tg = og / nx;
            if (og + 1u == (tg + 1u) * nx) xb_add(&bar[XB_TOPGEN], 1u);
            else XB_SPIN(xb_ld(&bar[XB_TOPGEN]) == tg, bar);
            __builtin_amdgcn_fence(__ATOMIC_ACQUIRE, "agent");
            xb_add(&bar[XB_XGEN(b.x)], 1u);
            asm volatile("s_waitcnt vmcnt(0)" ::: "memory");
        } else {
            XB_SPIN(xb_ld(&bar[XB_XGEN(b.x)]) == gen, bar);
            __builtin_amdgcn_fence(__ATOMIC_ACQUIRE, "agent");
            asm volatile("s_waitcnt vmcnt(0)" ::: "memory");
        }
    }
    __syncthreads();
}

namespace pg8 {
constexpr int BM = 256, BK = 64, HALF = 128, HTB = HALF * BK * 2, STAGE_BYTES = 8 * HTB, NXCD = 8, WGM = 8;
__host__ __device__ __forceinline__ int lds_byte(int r, int c) { const int st = (r >> 4) * 2 + (c >> 5), rr = r & 15, cc = c & 31, ob = rr * 64 + cc * 2; return st * 1024 + (ob ^ (((ob >> 9) & 1) << 5)); }
__host__ __device__ __forceinline__ void stage_rc(int b, int& R, int& C) { const int st = b / 1024, sb = b % 1024, swz = sb ^ (((sb >> 9) & 1) << 5); R = (st >> 1) * 16 + swz / 64; C = (st & 1) * 32 + (swz % 64) / 2; }
__host__ __device__ __forceinline__ int perm32(int rho) { const int n = rho >> 4, i = rho & 15; return 8 * (i >> 2) + 4 * n + (i & 3); }

struct Unit { int pm, pn, e; };

struct DenseOrder {
    const char* A; const char* Bt; int K; int nM, nN, nwg, G, c;
    __device__ __forceinline__ void init(const void* A_, const void* Bt_, int M, int N, int K_, int G_, int c_) { A = (const char*)A_; Bt = (const char*)Bt_; K = K_; nM = M / BM; nN = N / BM; nwg = nM * nN; G = G_; c = c_; }
    __device__ __forceinline__ bool next(int i, Unit& u) const {
        const long L = (long)i * G + c; if (L >= nwg) return false;
        int wgid = (int)L; { const int q = nwg / NXCD, r = nwg % NXCD, xcd = wgid % NXCD, off = wgid / NXCD; wgid = (xcd < r ? xcd * (q + 1) : r * (q + 1) + (xcd - r) * q) + off; }
        const int nig = WGM * nN, gid = wgid / nig, fm = gid * WGM, gsz = (nM - fm) < WGM ? (nM - fm) : WGM;
        u.pm = fm + ((wgid % nig) % gsz); u.pn = (wgid % nig) / gsz; u.e = 0; return true;
    }
    __device__ __forceinline__ const char* a_ptr(const Unit& u) const { return A + (size_t)u.pm * ((size_t)BM * K * 2); }
    __device__ __forceinline__ const char* b_ptr(const Unit& u) const { return Bt + (size_t)u.pn * ((size_t)BM * K * 2); }
    __device__ __forceinline__ const int* rows(const Unit&) const { return nullptr; }
};
struct GroupedOrder {
    const char* A; const char* Bt; size_t estride; int K; const int* rowidx; const LAS int* ulist;
    static constexpr int GO_MAXU = 48, LIST_OFF = 131072;
    __device__ __forceinline__ void build(LAS unsigned char* lds, const int* tstart, int nN, int G, int c) {
        LAS int* L = (LAS int*)(lds + LIST_OFF); ulist = L;
        if (threadIdx.x < GO_MAXU) {
            const int i = threadIdx.x; int Gx, x, j, nlab;
            if (G % 8 == 0) { Gx = G >> 3; x = c & 7; j = c >> 3; nlab = 8; } else { Gx = G; x = 0; j = c; nlab = 1; }
            const int q = j + Gx * i; int tq = q / nN; const int pn = q - tq * nN; int pm = 0, ee = 0, ok = 0;
            for (int e = x; e < NEXP; e += nlab) { const int s0 = tstart[e], cnt = tstart[e + 1] - s0; if (tq < cnt) { pm = s0 + tq; ee = e; ok = 1; break; } tq -= cnt; }
            L[4 * i] = pm; L[4 * i + 1] = pn; L[4 * i + 2] = ee; L[4 * i + 3] = ok;
        }
        __syncthreads();
    }
    __device__ __forceinline__ bool next(int i, Unit& u) const {
        if (i >= GO_MAXU) return false;
        const LAS int* p = ulist + 4 * i; u.pm = p[0]; u.pn = p[1]; u.e = p[2]; return p[3] != 0;
    }
    __device__ __forceinline__ const char* a_ptr(const Unit& u) const { return rowidx ? A : A + (size_t)u.pm * ((size_t)BM * K * 2); }
    __device__ __forceinline__ const char* b_ptr(const Unit& u) const { return Bt + (size_t)u.e * estride + (size_t)u.pn * ((size_t)BM * K * 2); }
    __device__ __forceinline__ const int* rows(const Unit& u) const { return rowidx + u.pm * BM; }
};

typedef int v4i_t __attribute__((ext_vector_type(4)));
typedef int v8i_t __attribute__((ext_vector_type(8)));
template <class Epi, class Sched, bool GATHER, bool F8 = false>
__device__ __forceinline__ void gemm_phase(LAS unsigned char* lds, const int K, const Sched& S, const Epi& E) {
    const int tid = threadIdx.x, wid = __builtin_amdgcn_readfirstlane(tid >> 6), lane = tid & 63, wr = wid >> 2, wc = wid & 3, fr = lane & 15, fq = lane >> 4;
    const int nt = K / BK;
    unsigned voffA[2], voffB[2], rA[2], cA2[2];
#pragma unroll
    for (int i = 0; i < 2; ++i) { int R, C; stage_rc(tid * 16 + i * 8192, R, C); const int Rb = Epi::PERM ? ((R & ~31) + perm32(R & 31)) : R;
        voffA[i] = (unsigned)(R * K + C) * 2u; voffB[i] = (unsigned)(Rb * K + C) * 2u; rA[i] = (unsigned)R; cA2[i] = (unsigned)C * 2u; }
    const size_t kstep = (size_t)(BK * 2);
    const size_t hstep = (size_t)HALF * K * 2;
    const unsigned ldsw = (unsigned)wid * 1024u;
    const int aoff = lds_byte(wr * 64 + fr, fq * 8), boff = lds_byte(wc * 32 + fr, fq * 8);
#define PG8_SA(b, h) (((b) * 2 + (h)) * HTB)
#define PG8_SB(b, h) ((4 + (b) * 2 + (h)) * HTB)
#define PG8_STAGE(bufoff, gbase, voff) do { _Pragma("unroll") for (int _i = 0; _i < 2; ++_i) \
        __builtin_amdgcn_global_load_lds((const unsigned*)((const char*)(gbase) + (voff)[_i]), (LAS unsigned*)(lds + (bufoff) + ldsw + _i * 8192), 16, 0, 0); } while (0)
#define PG8_STAGE_A(bufoff, base, h, GV) do { if constexpr (GATHER) { PG8_STAGE(bufoff, base, (GV)[h]); } else { PG8_STAGE(bufoff, (base) + (h) * hstep, voffA); } } while (0)
#define PG8_LD8(p) __builtin_shufflevector(*(const LAS v4i_t*)(p), *(const LAS v4i_t*)((p) + 1024), 0, 1, 2, 3, 4, 5, 6, 7)
#define PG8_LDA(dst, b, h) do { _Pragma("unroll") for (int m = 0; m < 4; ++m) { if constexpr (F8) dst##8[m] = PG8_LD8(lds + PG8_SA(b, h) + aoff + m * 2048); else { \
        _Pragma("unroll") for (int k = 0; k < 2; ++k) dst[m][k] = *(const LAS bf16x8*)(lds + PG8_SA(b, h) + aoff + m * 2048 + k * 1024); } } } while (0)
#define PG8_LDB(dst, b, h) do { _Pragma("unroll") for (int n = 0; n < 2; ++n) { if constexpr (F8) dst##8[n] = PG8_LD8(lds + PG8_SB(b, h) + boff + n * 2048); else { \
        _Pragma("unroll") for (int k = 0; k < 2; ++k) dst[n][k] = *(const LAS bf16x8*)(lds + PG8_SB(b, h) + boff + n * 2048 + k * 1024); } } } while (0)
#define PG8_MMA(ai, bj, At, Bt) do { __builtin_amdgcn_s_setprio(1); _Pragma("unroll") for (int m = 0; m < 4; ++m) _Pragma("unroll") for (int n = 0; n < 2; ++n) { \
        if constexpr (F8) { \
            asm volatile("v_mfma_scale_f32_16x16x128_f8f6f4 %0, %1, %2, %0, %3, %3 op_sel_hi:[0,0,0]" : "+v"(acc[ai][bj][m][n]) : "v"(Bt##8[n]), "v"(At##8[m]), "v"(f8one)); } \
        else { _Pragma("unroll") for (int k = 0; k < 2; ++k) acc[ai][bj][m][n] = __builtin_amdgcn_mfma_f32_16x16x32_bf16(Bt[n][k], At[m][k], acc[ai][bj][m][n], 0, 0, 0); } } \
        __builtin_amdgcn_s_setprio(0); } while (0)
#define PG8_WAIT_V(n) asm volatile("s_waitcnt vmcnt(" #n ")" ::: "memory")
#define PG8_WAIT_L(n) asm volatile("s_waitcnt lgkmcnt(" #n ")" ::: "memory")
#define PG8_BAR __builtin_amdgcn_s_barrier()
#define PG8_SCHED __builtin_amdgcn_sched_barrier(0)
#define PG8_ROWS(GV, u) do { const int* _rp = S.rows(u); _Pragma("unroll") for (int _h = 0; _h < 2; ++_h) _Pragma("unroll") for (int _i = 0; _i < 2; ++_i) \
        (GV)[_h][_i] = (unsigned)_rp[128 * _h + rA[_i]] * (unsigned)(K * 2) + cA2[_i]; } while (0)
    Unit cur, nxt; int ui = 0;
    if (!S.next(0, cur)) return;
    f32x4 acc[2][2][4][2];
#pragma unroll
    for (int a = 0; a < 2; ++a)
#pragma unroll
        for (int b = 0; b < 2; ++b)
#pragma unroll
            for (int m = 0; m < 4; ++m)
#pragma unroll
                for (int n = 0; n < 2; ++n) acc[a][b][m][n] = (f32x4){0.f, 0.f, 0.f, 0.f};
    const int f8one = 0x7f7f7f7f;
    bf16x8 At[4][2], B0[2][2], B1[2][2]; v8i_t At8[4], B08[2], B18[2];
    unsigned cv[2][2] = {{0u, 0u}, {0u, 0u}}, nv[2][2] = {{0u, 0u}, {0u, 0u}};
    const char* cA = S.a_ptr(cur); const char* cB = S.b_ptr(cur);
    if constexpr (GATHER) PG8_ROWS(cv, cur);
    PG8_STAGE(PG8_SB(0, 0), cB, voffB); PG8_STAGE(PG8_SB(0, 1), cB + hstep, voffB); PG8_STAGE_A(PG8_SA(0, 0), cA, 0, cv); PG8_STAGE_A(PG8_SA(0, 1), cA, 1, cv);
    if (wr == 1) PG8_BAR;
    PG8_WAIT_V(2); PG8_BAR;
    PG8_STAGE(PG8_SB(1, 0), cB + kstep, voffB); PG8_STAGE_A(PG8_SA(1, 0), cA + kstep, 0, cv); PG8_STAGE(PG8_SB(1, 1), cB + hstep + kstep, voffB);
    PG8_WAIT_V(6); PG8_BAR;
    for (;;) {
        const bool has_next = S.next(ui + 1, nxt);
        const char* nA = has_next ? S.a_ptr(nxt) : cA; const char* nB = has_next ? S.b_ptr(nxt) : cB;
        if constexpr (GATHER) { if (has_next) PG8_ROWS(nv, nxt); else {
#pragma unroll
            for (int h = 0; h < 2; ++h)
#pragma unroll
                for (int i = 0; i < 2; ++i) nv[h][i] = cv[h][i]; } }
        for (int t = 0; t < nt; t += 2) {
            const bool last = (t == nt - 2);
            if constexpr (Epi::MIDK) { if (t == nt / 2) { if constexpr (F8) asm volatile("s_nop 15\n\ts_nop 15" ::: "memory"); E.midk(acc, ui, wr, fr, lds); } }
            const char* a1 = cA + (size_t)(t + 1) * kstep;
            const char* a2 = last ? nA : cA + (size_t)(t + 2) * kstep; const char* b2 = last ? nB : cB + (size_t)(t + 2) * kstep;
            const char* a3 = a2 + kstep; const char* b3 = b2 + kstep;
            unsigned av[2][2];
#pragma unroll
            for (int h = 0; h < 2; ++h)
#pragma unroll
                for (int i = 0; i < 2; ++i) av[h][i] = last ? nv[h][i] : cv[h][i];
            PG8_LDB(B0, 0, 0); PG8_LDB(B1, 0, 1); PG8_SCHED; PG8_LDA(At, 0, 0); PG8_STAGE_A(PG8_SA(1, 1), a1, 1, cv);
            PG8_WAIT_V(8); PG8_WAIT_L(0); PG8_BAR; PG8_MMA(0, 0, At, B0); PG8_MMA(0, 1, At, B1); PG8_BAR; PG8_SCHED;
            PG8_LDA(At, 0, 1); PG8_STAGE(PG8_SB(0, 0), b2, voffB); PG8_STAGE(PG8_SB(0, 1), b2 + hstep, voffB); PG8_STAGE_A(PG8_SA(0, 0), a2, 0, av);
            PG8_WAIT_V(8); PG8_WAIT_L(0); PG8_BAR; PG8_MMA(1, 0, At, B0); PG8_MMA(1, 1, At, B1); PG8_BAR; PG8_SCHED;
            PG8_LDB(B0, 1, 0); PG8_LDB(B1, 1, 1); PG8_SCHED; PG8_LDA(At, 1, 0); PG8_STAGE_A(PG8_SA(0, 1), a2, 1, av);
            PG8_WAIT_V(8); PG8_WAIT_L(0); PG8_BAR; PG8_MMA(0, 0, At, B0); PG8_MMA(0, 1, At, B1); PG8_BAR; PG8_SCHED;
            PG8_LDA(At, 1, 1); PG8_STAGE(PG8_SB(1, 0), b3, voffB); PG8_STAGE(PG8_SB(1, 1), b3 + hstep, voffB); PG8_STAGE_A(PG8_SA(1, 0), a3, 0, av);
            PG8_WAIT_V(8); PG8_WAIT_L(0); PG8_BAR; PG8_MMA(1, 0, At, B0); PG8_MMA(1, 1, At, B1); PG8_BAR; PG8_SCHED;
        }
        if constexpr (F8) asm volatile("s_nop 15\n\ts_nop 15\n\ts_nop 7" ::: "memory");
        if (wr == 0) PG8_BAR;
        for (int er = 0; er < (Epi::PROBE_REP ? EPI_REPS : 1); ++er) { if constexpr (Epi::MIDK) E.fin(acc, cur, ui, wr, wc, fr, fq, lds); else E(acc, cur, wr, wc, fr, fq); }
        if (!has_next) break;
#pragma unroll
        for (int a = 0; a < 2; ++a)
#pragma unroll
            for (int b = 0; b < 2; ++b)
#pragma unroll
                for (int m = 0; m < 4; ++m)
#pragma unroll
                    for (int n = 0; n < 2; ++n) acc[a][b][m][n] = (f32x4){0.f, 0.f, 0.f, 0.f};
        cur = nxt; cA = nA; cB = nB; ++ui;
#pragma unroll
        for (int h = 0; h < 2; ++h)
#pragma unroll
            for (int i = 0; i < 2; ++i) cv[h][i] = nv[h][i];
        if (wr == 1) PG8_BAR;
    }
    PG8_WAIT_V(0);
    PG8_BAR;
#undef PG8_SA
#undef PG8_SB
#undef PG8_STAGE
#undef PG8_STAGE_A
#undef PG8_LDA
#undef PG8_LDB
#undef PG8_MMA
#undef PG8_LD8
#undef PG8_WAIT_V
#undef PG8_WAIT_L
#undef PG8_BAR
#undef PG8_SCHED
#undef PG8_ROWS
}

struct EpiQKV {
    static constexpr bool PERM = true, PROBE_REP = false, MIDK = false;
    bf16* O; bf16* KVH;
    __device__ __forceinline__ void operator()(const f32x4 (&acc)[2][2][4][2], const Unit& u, int wr, int wc, int fr, int fq) const {
        const int row0 = u.pm * BM + wr * 64 + fr;
        const bool isq = (u.pn < 4 || (u.pn >= 6 && u.pn < 10));
        const size_t tb = (u.pn == 4) ? KVH_KA : (u.pn == 5) ? KVH_VA : (u.pn < 14) ? KVH_KB + (size_t)(u.pn - 10) * 4 * NT * 64 * 2 : KVH_VB + (size_t)(u.pn - 14) * 4 * NT * 64 * 2;
        bf16* P = isq ? O : (bf16*)((unsigned char*)KVH + tb);
        const int pitch = isq ? DIN : 64; const float sc = isq ? 0.125f * LOG2E : 1.0f;
        const int cin = wc * 32 + 8 * fq;
        size_t coff[2];
#pragma unroll
        for (int bj = 0; bj < 2; ++bj) { const int c = bj * HALF + cin; coff[bj] = isq ? (size_t)(u.pn * BM + c) : ((size_t)(c >> 6) * NT * 64 + (c & 63)); }
#pragma unroll
        for (int ai = 0; ai < 2; ++ai)
#pragma unroll
            for (int m = 0; m < 4; ++m) { bf16* rowp = P + (size_t)(row0 + ai * HALF + m * 16) * pitch;
#pragma unroll
                for (int bj = 0; bj < 2; ++bj) { const f32x4 v0 = acc[ai][bj][m][0] * sc, v1 = acc[ai][bj][m][1] * sc;
                    u32x4 w; w.x = cvtpk(v0[0], v0[1]); w.y = cvtpk(v0[2], v0[3]); w.z = cvtpk(v1[0], v1[1]); w.w = cvtpk(v1[2], v1[3]);
                    *(u32x4*)(rowp + coff[bj]) = w; } }
    }
};
struct EpiRes {
    static constexpr bool PERM = true, PROBE_REP = true, MIDK = true;
    const float* X; bf16* X1; const float* mod; const float* SSQ; float* RSS;
    static constexpr int TAB_OFF = 131072;
    __device__ __forceinline__ void midk(f32x4 (&acc)[2][2][4][2], int ui, int wr, int fr, LAS unsigned char* lds) const {
        const LAS float* tab = (const LAS float*)(lds + TAB_OFF) + (size_t)ui * 512;
#pragma unroll
        for (int ai = 0; ai < 2; ++ai)
#pragma unroll
            for (int m = 0; m < 4; ++m) { const float ratio = tab[2 * (ai * HALF + wr * 64 + m * 16 + fr)];
#pragma unroll
                for (int bj = 0; bj < 2; ++bj)
#pragma unroll
                    for (int n = 0; n < 2; ++n) acc[ai][bj][m][n] = acc[ai][bj][m][n] * ratio; }
    }
    __device__ __forceinline__ void fin(const f32x4 (&acc)[2][2][4][2], const Unit& u, int ui, int wr, int wc, int fr, int fq, LAS unsigned char* lds) const {
        const LAS float* tab = (const LAS float*)(lds + TAB_OFF) + (size_t)ui * 512;
        const int row0 = u.pm * BM + wr * 64 + fr, col0 = u.pn * BM + wc * 32 + 8 * fq;
        const float* gt = mod + (size_t)(u.pm >> 4) * 16384 + 4096;
        f32x4 gv[2][2];
#pragma unroll
        for (int bj = 0; bj < 2; ++bj)
#pragma unroll
            for (int n = 0; n < 2; ++n) gv[bj][n] = *(const f32x4*)(gt + col0 + bj * HALF + 4 * n);
        f32x4 xl[8][2][2];
#define ER_LOAD(it) do { const size_t _off = (size_t)(u.pm * BM + ((it) >> 2) * HALF + wr * 64 + ((it) & 3) * 16 + fr) * DM + col0; _Pragma("unroll") for (int bj = 0; bj < 2; ++bj) { \
            xl[it][bj][0] = __builtin_nontemporal_load((const f32x4*)(X + _off + bj * HALF)); xl[it][bj][1] = __builtin_nontemporal_load((const f32x4*)(X + _off + bj * HALF + 4)); } } while (0)
        ER_LOAD(0); ER_LOAD(1);
#pragma unroll
        for (int it = 0; it < 8; ++it) { const int ai = it >> 2, m = it & 3;
            if (it + 2 < 8) ER_LOAD(it + 2);
            asm volatile("" ::: "memory");
            const int rl = ai * HALF + wr * 64 + m * 16 + fr; const size_t off = (size_t)(u.pm * BM + rl) * DM + col0;
            const float rB = tab[2 * rl + 1];
#pragma unroll
            for (int bj = 0; bj < 2; ++bj) { const f32x4 x0 = xl[it][bj][0], x1 = xl[it][bj][1];
                const f32x4 v0 = x0 + gv[bj][0] * (acc[ai][bj][m][0] * rB), v1 = x1 + gv[bj][1] * (acc[ai][bj][m][1] * rB);
                u32x4 w; w.x = cvtpk(v0[0], v0[1]); w.y = cvtpk(v0[2], v0[3]); w.z = cvtpk(v1[0], v1[1]); w.w = cvtpk(v1[2], v1[3]);
                *(u32x4*)(X1 + off + bj * HALF) = w;
                float p = (v0[0] * v0[0] + v0[1] * v0[1]) + (v0[2] * v0[2] + v0[3] * v0[3]) + (v1[0] * v1[0] + v1[1] * v1[1]) + (v1[2] * v1[2] + v1[3] * v1[3]);
                p += __shfl_xor(p, 16); p += __shfl_xor(p, 32);
                if (fq == 0) RSS[(size_t)(u.pm * BM + rl) * 64 + u.pn * 8 + wc * 2 + bj] = p; }
            asm volatile("" ::: "memory"); }
#undef ER_LOAD
        (void)row0;
    }
    __device__ __forceinline__ void operator()(const f32x4 (&)[2][2][4][2], const Unit&, int, int, int, int) const {}
};
struct EpiGU {
    static constexpr bool PERM = true, PROBE_REP = false, MIDK = false;
    unsigned char* ACT;
    __device__ __forceinline__ void operator()(const f32x4 (&acc)[2][2][4][2], const Unit& u, int wr, int wc, int fr, int fq) const {
        const int row0 = u.pm * BM + wr * 64 + fr, col0 = u.pn * 128 + wc * 32 + 8 * fq; constexpr float us = 1.0f / (F8_SH * F8_SWGU);
#pragma unroll
        for (int ai = 0; ai < 2; ++ai)
#pragma unroll
            for (int m = 0; m < 4; ++m) { float r[8];
#pragma unroll
                for (int n = 0; n < 2; ++n)
#pragma unroll
                    for (int j = 0; j < 4; ++j) { const float g = acc[ai][0][m][n][j] * us, up = acc[ai][1][m][n][j] * us;
                        r[4 * n + j] = g * __builtin_amdgcn_rcpf(1.0f + __expf(-g)) * up * F8_SACT; }
                u32x2 w; w.x = cvt4_fp8(r[0], r[1], r[2], r[3]); w.y = cvt4_fp8(r[4], r[5], r[6], r[7]);
                *(u32x2*)(ACT + (size_t)(row0 + ai * HALF + m * 16) * DE + col0) = w; }
    }
};
struct EpiY {
    static constexpr bool PERM = true, PROBE_REP = false, MIDK = false;
    unsigned char* Y;
    __device__ __forceinline__ void operator()(const f32x4 (&acc)[2][2][4][2], const Unit& u, int wr, int wc, int fr, int fq) const {
        const int row0 = u.pm * BM + wr * 64 + fr, col0 = u.pn * BM + wc * 32 + 8 * fq;
#pragma unroll
        for (int ai = 0; ai < 2; ++ai)
#pragma unroll
            for (int m = 0; m < 4; ++m) { unsigned char* rowp = Y + (size_t)(row0 + ai * HALF + m * 16) * DM + col0;
#pragma unroll
                for (int bj = 0; bj < 2; ++bj) { constexpr float us = F8_SY / (F8_SACT * F8_SWD); const f32x4 v0 = acc[ai][bj][m][0] * us, v1 = acc[ai][bj][m][1] * us;
                    u32x2 w; w.x = cvt4_fp8(v0[0], v0[1], v0[2], v0[3]); w.y = cvt4_fp8(v1[0], v1[1], v1[2], v1[3]);
                    *(u32x2*)(rowp + bj * HALF) = w; } }
    }
};
}

struct Args { const float* in[22]; float* out; unsigned char* ws; int ph_lo, ph_hi; };
struct InPtrs {
    __device__ __forceinline__ const float* operator[](int k) const {
        const __attribute__((address_space(4))) char* p = (const __attribute__((address_space(4))) char*)__builtin_amdgcn_kernarg_segment_ptr();
        asm volatile("" : "+s"(p));
        return *(const float* const __attribute__((address_space(4)))*)(p + 8 * k);
    }
};
struct Ctx { InPtrs in; float* out; unsigned char* ws; };
static_assert(__builtin_offsetof(Args, in) == 0, "InPtrs reads Args::in at kernarg offset 0");
enum { I_X = 0, I_C, I_WADA, I_BADA, I_GMIX, I_WIN, I_SINKS, I_RELB, I_GOA, I_GOB, I_WOUT, I_GFFN, I_WRG, I_BRG, I_WRE, I_BRE, I_WGATE, I_WUP, I_WDOWN, I_WADAF, I_BADAF, I_GFIN };

__device__ __forceinline__ void p0_mod(const Ctx& a, LAS unsigned char* lds, int tid, int lane, int wave) {
    LAS float* cact = (LAS float*)lds;
    LAS float* red = (LAS float*)(lds + 32768);
    const float* c = a.in[I_C];
    for (int i = tid; i < 2048 * 4; i += 512) { const int b = i >> 11, k = i & 2047; const float v = c[i]; cact[k * 4 + b] = v / (1.0f + __expf(-v)); }
    __syncthreads();
    float* mod = (float*)(a.ws + WS_MOD);
    const int rsub = lane >> 4, cq = lane & 15;
    for (int cg = blockIdx.x; cg < 256; cg += gridDim.x) {
        const int col0 = cg * 64;
        const float* W; int ldw; const float* bias; int cc;
        if (col0 < 12288) { W = a.in[I_WADA]; ldw = 12288; bias = a.in[I_BADA]; cc = col0; } else { W = a.in[I_WADAF]; ldw = 4096; bias = a.in[I_BADAF]; cc = col0 - 12288; }
        float acc[4][4];
#pragma unroll
        for (int b = 0; b < 4; ++b)
#pragma unroll
            for (int j = 0; j < 4; ++j) acc[b][j] = 0.f;
        const float* wp = W + (size_t)(wave * 256 + rsub) * ldw + cc + 4 * cq;
#pragma unroll 8
        for (int i = 0; i < 64; ++i) {
            const f32x4 wv = __builtin_nontemporal_load((const f32x4*)(wp + (size_t)(4 * i) * ldw));
            const f32x4 ca = *(const LAS f32x4*)(cact + (wave * 256 + 4 * i + rsub) * 4);
#pragma unroll
            for (int b = 0; b < 4; ++b)
#pragma unroll
                for (int j = 0; j < 4; ++j) acc[b][j] += ca[b] * wv[j];
        }
#pragma unroll
        for (int b = 0; b < 4; ++b)
#pragma unroll
            for (int j = 0; j < 4; ++j) { float v = acc[b][j]; v += __shfl_xor(v, 16); v += __shfl_xor(v, 32); if (lane < 16) red[(wave * 4 + b) * 64 + 4 * cq + j] = v; }
        __syncthreads();
        if (tid < 256) { const int b = tid >> 6, col = tid & 63; float s = bias[cc + col];
#pragma unroll
            for (int w = 0; w < 8; ++w) s += red[(w * 4 + b) * 64 + col];
            mod[(size_t)b * 16384 + col0 + col] = s; }
        __syncthreads();
    }
}
template <bool NTS>
__device__ __forceinline__ void transpose_item(const float* W, int ldw, int k0, int n0, const float* kscale, bf16* dst, int Kd, LAS float* scr, int lane) {
    const int r = lane >> 4, q = lane & 15;
#pragma unroll 4
    for (int i = 0; i < 16; ++i) { const int kk = 4 * i + r; f32x4 v = __builtin_nontemporal_load((const f32x4*)(W + (size_t)(k0 + kk) * ldw + n0 + 4 * q));
        if (kscale) { const float s = kscale[k0 + kk]; v = v * s; }
        LAS float* sp = scr + kk * 65 + 4 * q; sp[0] = v[0]; sp[1] = v[1]; sp[2] = v[2]; sp[3] = v[3]; }
    LDS_WAIT();
    const int c = lane & 7;
#pragma unroll
    for (int j = 0; j < 8; ++j) { const int n = (lane >> 3) + 8 * j; const LAS float* s = scr + (8 * c) * 65 + n;
        u32x4 o; o.x = cvtpk(s[0 * 65], s[1 * 65]); o.y = cvtpk(s[2 * 65], s[3 * 65]); o.z = cvtpk(s[4 * 65], s[5 * 65]); o.w = cvtpk(s[6 * 65], s[7 * 65]);
        if (NTS) __builtin_nontemporal_store(o, (u32x4*)(dst + (size_t)n * Kd + 8 * c)); else *(u32x4*)(dst + (size_t)n * Kd + 8 * c) = o; }
    LDS_WAIT();
}
template <bool NTS>
__device__ __forceinline__ void transpose_item8(const float* W, int ldw, int k0, int n0, float scale, const float* kscale, unsigned char* dst8, int Kd, LAS float* scr, int lane) {
    const int r = lane >> 3, q = lane & 7;
    f32x4 v[16];
#pragma unroll
    for (int i = 0; i < 16; ++i) v[i] = __builtin_nontemporal_load((const f32x4*)(W + (size_t)(k0 + 8 * i + r) * ldw + n0 + 4 * q));
#pragma unroll
    for (int i = 0; i < 16; ++i) { if (kscale) v[i] = v[i] * kscale[k0 + 8 * i + r]; LAS float* sp = scr + (8 * i + r) * 33 + 4 * q; sp[0] = v[i][0]; sp[1] = v[i][1]; sp[2] = v[i][2]; sp[3] = v[i][3]; }
    LDS_WAIT();
    const int c = lane >> 3, nl = lane & 7;
#pragma unroll
    for (int j = 0; j < 4; ++j) { const int n = nl + 8 * j; const LAS float* sq = scr + (16 * c) * 33 + n; u32x4 o;
        o.x = cvt4_fp8(sq[0 * 33] * scale, sq[1 * 33] * scale, sq[2 * 33] * scale, sq[3 * 33] * scale); o.y = cvt4_fp8(sq[4 * 33] * scale, sq[5 * 33] * scale, sq[6 * 33] * scale, sq[7 * 33] * scale);
        o.z = cvt4_fp8(sq[8 * 33] * scale, sq[9 * 33] * scale, sq[10 * 33] * scale, sq[11 * 33] * scale); o.w = cvt4_fp8(sq[12 * 33] * scale, sq[13 * 33] * scale, sq[14 * 33] * scale, sq[15 * 33] * scale);
        if (NTS) __builtin_nontemporal_store(o, (u32x4*)(dst8 + (size_t)n * Kd + 16 * c)); else *(u32x4*)(dst8 + (size_t)n * Kd + 16 * c) = o; }
    LDS_WAIT();
}
constexpr int CV_IN = 32 * 72, CV_OUT = 32 * 32, CV_G = 32 * 256, CV_D = 32 * 256;
constexpr int CV_UP0 = CV_IN + CV_OUT + CV_G, CV_DN0 = CV_UP0 + CV_G, CV_ALL = CV_DN0 + CV_D;
constexpr int CV_G_P4 = CV_IN + CV_OUT + 20 * 256;
constexpr int CV_UP_TAIL = CV_UP0 + 10 * 256, CV_DN_TAIL = CV_DN0 + 0 * 256;
__device__ __forceinline__ void convert_items(const Ctx& a, LAS unsigned char* lds, int lane, int wave, int first, int last, int gw, int NGW) {
    LAS float* scr = (LAS float*)(lds + wave * 16896);
    bf16* WinT = (bf16*)(a.ws + WS_WIN); unsigned char* WoutT = a.ws + WS_WOUT; unsigned char* WguT = a.ws + WS_WGU; unsigned char* WdT = a.ws + WS_WD;
    for (int it = first + gw; it < last; it += NGW) {
        int r = it;
        if (r < CV_IN) { const int kb = r / 72, nb = r % 72; transpose_item<false>(a.in[I_WIN], DIN, 64 * kb, 64 * nb, nullptr, WinT + (size_t)(64 * nb) * DM + 64 * kb, DM, scr, lane); continue; } r -= CV_IN;
        if (r < CV_OUT) { const int kb = r >> 6, nb = r & 63; const float* ks = (kb < 8) ? a.in[I_GOA] : (a.in[I_GOB] - 1024);
            transpose_item8<true>(a.in[I_WOUT], DM, 128 * kb, 32 * nb, F8_SWO, ks, WoutT + (size_t)(32 * nb) * DM + 128 * kb, DM, scr, lane); continue; } r -= CV_OUT;
        if (r < 2 * CV_G) { const int up = r >= CV_G ? 1 : 0; if (up) r -= CV_G; const int e = r >> 8, rr = r & 255, kb = rr >> 4, nb = rr & 15, n0 = 32 * nb;
            const int drow = 256 * (n0 >> 7) + (n0 & 127) + 128 * up;
            transpose_item8<true>(a.in[up ? I_WUP : I_WGATE] + (size_t)e * DM * DE, DE, 128 * kb, n0, F8_SWGU, nullptr, WguT + ((size_t)e * 1024 + drow) * DM + 128 * kb, DM, scr, lane); continue; } r -= 2 * CV_G;
        { const int e = r >> 8, rr = r & 255, kb = rr >> 6, nb = rr & 63;
            transpose_item8<true>(a.in[I_WDOWN] + (size_t)e * DE * DM, DM, 128 * kb, 32 * nb, F8_SWD, nullptr, WdT + ((size_t)e * DM + 32 * nb) * DE + 128 * kb, DE, scr, lane); }
    }
}
__device__ __forceinline__ void p0_convert(const Ctx& a, LAS unsigned char* lds, int tid, int lane, int wave) {
    convert_items(a, lds, lane, wave, 0, CV_G_P4, blockIdx.x * 8 + wave, gridDim.x * 8);
    convert_items(a, lds, lane, wave, CV_UP0, CV_UP_TAIL, blockIdx.x * 8 + wave, gridDim.x * 8);
    convert_items(a, lds, lane, wave, CV_DN0, CV_DN_TAIL, blockIdx.x * 8 + wave, gridDim.x * 8);
    bf16* wrhi = (bf16*)(a.ws + WS_WRT); bf16* wrlo = wrhi + 48 * 2048;
    for (int i = blockIdx.x * 512 + tid; i < 48 * 2048; i += gridDim.x * 512) { const int col = i >> 11, k = i & 2047;
        const float v = col < 4 ? a.in[I_WRG][k * 4 + col] : (col < 36 ? a.in[I_WRE][k * 32 + col - 4] : 0.f);
        const unsigned h = cvtpk(v, 0.f); const float hf = bf_lo(h); const unsigned l = cvtpk(v - hf, 0.f);
        wrhi[i] = (bf16)(h & 0xffffu); wrlo[i] = (bf16)(l & 0xffffu); }
}

__device__ __forceinline__ void p1_norm(const Ctx& a, int lane, int wave) {
    const float* x = a.in[I_X]; const float* g = a.in[I_GMIX]; const float* mod = (const float*)(a.ws + WS_MOD); bf16* H = (bf16*)(a.ws + WS_H);
    const int gw = blockIdx.x * 8 + wave, NGW = gridDim.x * 8;
    { float* aux = (float*)(a.ws + WS_AUX);
      for (int i = gw; i < 4 * 36; i += NGW) { const int b = i / 36, c = i % 36; const float* sh = mod + (size_t)b * 16384 + 6144; float sacc = 0.f;
          for (int k = lane; k < DM; k += 64) sacc += sh[k] * (c < 4 ? a.in[I_WRG][k * 4 + c] : a.in[I_WRE][k * 32 + c - 4]);
          sacc = wave_sum(sacc); if (lane == 0) aux[b * 48 + c] = sacc + (c < 4 ? a.in[I_BRG][c] : a.in[I_BRE][c - 4]); }
      for (int i = blockIdx.x * 512 + threadIdx.x; i < 4 * DM; i += gridDim.x * 512) { const int b = i >> 11, k = i & 2047; aux[1024 + i] = a.in[I_GFFN][k] * (1.0f + mod[(size_t)b * 16384 + 8192 + k]); } }
    for (int grp = gw; grp < NT / 8; grp += NGW) {
        const int row0 = grp * 8, b = row0 >> 12;
        f32x4 A[8], Bv[8];
#pragma unroll
        for (int j = 0; j < 8; ++j) { const int k = 4 * lane + 256 * j; const f32x4 gg = *(const f32x4*)(g + k), sc = *(const f32x4*)(mod + (size_t)b * 16384 + 2048 + k);
            A[j] = gg * (1.0f + sc); Bv[j] = *(const f32x4*)(mod + (size_t)b * 16384 + k); }
        for (int r = 0; r < 8; ++r) {
            const float* xr = x + (size_t)(row0 + r) * DM + 4 * lane; f32x4 v[8]; float s = 0.f;
#pragma unroll
            for (int j = 0; j < 8; ++j) { v[j] = __builtin_nontemporal_load((const f32x4*)(xr + 256 * j)); s += (v[j][0] * v[j][0] + v[j][1] * v[j][1]) + (v[j][2] * v[j][2] + v[j][3] * v[j][3]); }
            const float rstd = __builtin_amdgcn_rsqf(wave_sum(s) * (1.0f / DM) + EPS);
            bf16* hr = H + (size_t)(row0 + r) * DM + 4 * lane;
#pragma unroll
            for (int j = 0; j < 8; ++j) { const f32x4 h = v[j] * rstd * A[j] + Bv[j]; u32x2 w; w.x = cvtpk(h[0], h[1]); w.y = cvtpk(h[2], h[3]); *(u32x2*)(hr + 256 * j) = w; }
        }
    }
}

__device__ __forceinline__ void att_glds16(unsigned voff, const void* sbase, unsigned lds_dst) { unsigned keep;
    asm volatile("s_mov_b32 %0, m0\n\ts_mov_b32 m0, %3\n\ts_nop 0\n\tglobal_load_lds_dwordx4 %1, %2\n\ts_mov_b32 m0, %0" : "=&s"(keep) : "v"(voff), "s"(sbase), "s"(lds_dst) : "memory"); }
__device__ __forceinline__ void att_dma_tile(const bf16* base, unsigned lds0, unsigned vo0, unsigned vo1) {
    unsigned keep;
#pragma unroll
    for (int h = 0; h < 2; ++h) {
        asm volatile("s_mov_b32 %0, m0\n\ts_mov_b32 m0, %4\n\ts_nop 0\n\t"
                     "global_load_lds_dwordx4 %1, %3\n\tglobal_load_lds_dwordx4 %2, %3 offset:1024\n\tglobal_load_lds_dwordx4 %1, %3 offset:2048\n\tglobal_load_lds_dwordx4 %2, %3 offset:3072\n\t"
                     "s_mov_b32 m0, %0" : "=&s"(keep) : "v"(vo0), "v"(vo1), "s"(base), "s"(lds0) : "memory");
        base += 4 * 8 * 64; lds0 += 4096u; asm volatile("" : "+s"(base), "+s"(lds0));
    }
}
#define ATT_DMAK(KB) att_dma_tile((KB), klu, kvo0, kvo0 ^ 64u)
#define ATT_DMAV(VB) att_dma_tile((VB), klu + 8192u, vvo, vvo)
__device__ __forceinline__ void att_scores(f32x16& s0, f32x16& s1, const bf16x8 (&qf)[4], const LAS unsigned char* kfp, int hh, int km, const LAS float* tbl,
                                           bool isA, int dd, float nslope2, float cb, int base0, float moff) {
    int bl = base0; asm volatile("" : "+v"(bl));
    const float fbl = (float)bl; float cadd = 0.f;
    if (isA) {
        if (dd > 0) { const float c00 = nslope2 * (fbl + 64.0f * (float)dd) - moff, c01 = c00 - 32.0f * nslope2;
#pragma unroll
            for (int r = 0; r < 16; ++r) { const float noff = -(float)((r & 3) + 8 * (r >> 2)); s0[r] = fmaf(nslope2, noff, c00); s1[r] = fmaf(nslope2, noff, c01); } }
        else { const float nm = -moff;
#pragma unroll
            for (int r = 0; r < 16; ++r) { const float off = (float)((r & 3) + 8 * (r >> 2)); s0[r] = fmaf(nslope2, fabsf(fbl - off), nm); s1[r] = fmaf(nslope2, fabsf(fbl - (off + 32.0f)), nm); } }
    } else if (dd >= 3) { cadd = cb - moff;
#pragma unroll
        for (int r = 0; r < 16; ++r) { s0[r] = 0.f; s1[r] = 0.f; }
    } else {
        const LAS float* p0 = tbl + (bl + 64 * dd + 64 - 27); const LAS float* p1 = p0 - 32;
#pragma unroll
        for (int r = 0; r < 16; ++r) { s0[r] = p0[27 - ((r & 3) + 8 * (r >> 2))] - moff; s1[r] = p1[27 - ((r & 3) + 8 * (r >> 2))] - moff; } }
    bf16x8 kf[8];
#pragma unroll
    for (int kt = 0; kt < 2; ++kt)
#pragma unroll
        for (int ks = 0; ks < 4; ++ks) kf[4 * kt + ks] = *(const LAS bf16x8*)(kfp + kt * 4096 + (((2 * ks + hh) ^ km) << 4));
#pragma unroll
    for (int ks = 0; ks < 4; ++ks) { s0 = __builtin_amdgcn_mfma_f32_32x32x16_bf16(kf[ks], qf[ks], s0, 0, 0, 0); s1 = __builtin_amdgcn_mfma_f32_32x32x16_bf16(kf[4 + ks], qf[ks], s1, 0, 0, 0); }
    if (!isA && dd >= 3) {
#pragma unroll
        for (int r = 0; r < 16; ++r) { s0[r] += cadd; s1[r] += cadd; } }
}
constexpr float ATT_THR = 4.0f;
template <bool FIRSTHALF>
__device__ __forceinline__ void att_softmax_pv(f32x16& s0, f32x16& s1, f32x16& o0, f32x16& o1, float& m2, float& l, const LAS unsigned char* vl, int tr0, bool first) {
    float mx = fmaxf(s0[0], s1[0]);
#pragma unroll
    for (int r = 1; r < 16; ++r) mx = fmaxf(fmaxf(mx, s0[r]), s1[r]);
    { const auto rr = __builtin_amdgcn_permlane32_swap(__float_as_uint(mx), __float_as_uint(mx), false, false); mx = fmaxf(__uint_as_float(rr[0]), __uint_as_float(rr[1])); }
    if (first || __any(mx > ATT_THR)) {
        float delta;
        if (first) { delta = mx; m2 = mx; }
        else { delta = fmaxf(mx, 0.f); m2 += delta; const float alpha = __builtin_amdgcn_exp2f(-delta); l *= alpha;
#pragma unroll
            for (int r = 0; r < 16; ++r) { float a0 = o0[r], a1 = o1[r]; asm volatile("v_mul_f32 %0, %2, %0\n\tv_mul_f32 %1, %2, %1" : "+v"(a0), "+v"(a1) : "v"(alpha)); o0[r] = a0; o1[r] = a1; } }
#pragma unroll
        for (int r = 0; r < 16; ++r) { float a0 = s0[r], a1 = s1[r]; asm volatile("v_sub_f32 %0, %0, %2\n\tv_sub_f32 %1, %1, %2" : "+v"(a0), "+v"(a1) : "v"(delta)); s0[r] = a0; s1[r] = a1; }
    }
    float rs = 0.f;
#pragma unroll
    for (int r = 0; r < 16; ++r) { s0[r] = __builtin_amdgcn_exp2f(s0[r]); s1[r] = __builtin_amdgcn_exp2f(s1[r]); rs += s0[r] + s1[r]; }
    l += rs;
    bf16x8 pb[2][2];
#pragma unroll
    for (int s = 0; s < 2; ++s) {
        u32x4 w0, w1;
        w0.x = cvtpk(s0[8 * s + 0], s0[8 * s + 1]); w0.y = cvtpk(s0[8 * s + 2], s0[8 * s + 3]); w0.z = cvtpk(s0[8 * s + 4], s0[8 * s + 5]); w0.w = cvtpk(s0[8 * s + 6], s0[8 * s + 7]);
        w1.x = cvtpk(s1[8 * s + 0], s1[8 * s + 1]); w1.y = cvtpk(s1[8 * s + 2], s1[8 * s + 3]); w1.z = cvtpk(s1[8 * s + 4], s1[8 * s + 5]); w1.w = cvtpk(s1[8 * s + 6], s1[8 * s + 7]);
        pb[0][s] = __builtin_bit_cast(bf16x8, w0); pb[1][s] = __builtin_bit_cast(bf16x8, w1); }
    if (FIRSTHALF) asm volatile("s_waitcnt vmcnt(0)" ::: "memory");
#pragma unroll
    for (int kt = 0; kt < 2; ++kt)
#pragma unroll
        for (int s = 0; s < 2; ++s)
#pragma unroll
            for (int dt = 0; dt < 2; ++dt) {
                const LAS unsigned char* ap = vl + (dt ? (tr0 ^ 64) : tr0) + (32 * kt + 16 * s) * 128;
                const s16x4 r1 = __builtin_bit_cast(s16x4, __builtin_amdgcn_ds_read_tr16_b64_v4i16((LAS s16x4*)ap));
                const s16x4 r2 = __builtin_bit_cast(s16x4, __builtin_amdgcn_ds_read_tr16_b64_v4i16((LAS s16x4*)(ap + 8 * 128)));
                const bf16x8 av = {r1[0], r1[1], r1[2], r1[3], r2[0], r2[1], r2[2], r2[3]};
                if (dt == 0) o0 = __builtin_amdgcn_mfma_f32_32x32x16_bf16(av, pb[kt][s], o0, 0, 0, 0);
                else o1 = __builtin_amdgcn_mfma_f32_32x32x16_bf16(av, pb[kt][s], o1, 0, 0, 0); }
}
__device__ __forceinline__ void p3_attn(const Ctx& a, LAS unsigned char* lds, int tid, int lane, int wave) {
    const bf16* qkv = (const bf16*)(a.ws + WS_QKV); unsigned char* O = a.ws + WS_O;
    const unsigned char* kvh = a.ws + WS_KVH;
    const float* sinks = a.in[I_SINKS]; const float* relb = a.in[I_RELB];
    LAS unsigned char* kl = lds + wave * 16384;
    LAS unsigned char* vl = kl + 8192;
    LAS float* tbl = (LAS float*)(lds + 131072 + wave * 1056);
    LAS float* ssqp = (LAS float*)(lds + 131072 + 8 * 1056);
    LAS float* rstd = (LAS float*)(lds + 131072 + 8 * 1056 + 8192);
    static_assert(131072 + 8 * 1056 + 8192 + 512 <= MISC_OFF, "attention LDS map");
    const int l31 = lane & 31, hh = lane >> 5;
    const int grp = lane >> 4, i16 = lane & 15;
    const int base0 = l31 - 4 * hh;
    const int vrow = lane >> 3, vch = lane & 7;
    const unsigned kvo0 = (unsigned)(vrow * 64 + 8 * (vch ^ ((lane >> 4) & 7))) * 2u, vvo = (unsigned)(vrow * 64 + 8 * (vch ^ (4 * ((lane >> 4) & 1)))) * 2u;
    const int km = (l31 >> 1) & 7, kro = l31 * 128;
    const int trrow = (4 * hh + (i16 >> 2)) * 128, trc0 = (2 * (grp & 1) + ((i16 & 3) >> 1)) ^ (4 * ((i16 >> 3) & 1));
    const int tr0 = trrow + trc0 * 16 + (i16 & 1) * 8;
    for (int u0 = blockIdx.x; u0 < 256; u0 += gridDim.x) {
        const int unit = (gridDim.x == 256) ? ((u0 & 7) * 32 + (u0 >> 3)) : u0;
        const int b = unit >> 6, ci = unit & 63, tok0 = b * SEQ + ci * 64;
        const int dmaxA = ci < 2 ? ci : 2, dmaxB = ci < 8 ? ci : 8;
        {
            const unsigned klu = (unsigned)(__UINTPTR_TYPE__)kl;
            const int kvn = wave >> 2, ktok0 = tok0;
            const bf16* kp = (const bf16*)(kvh + KVH_KA) + ((size_t)kvn * NT + ktok0) * 64; ATT_DMAK(kp);
            const bf16* vp = (const bf16*)(kvh + KVH_VA) + ((size_t)kvn * NT + ktok0) * 64; ATT_DMAV(vp);
        }
        for (int it = 0; it < 4; ++it) {
            const int head = wave + 8 * it;
            const bool isA = it < 2;
            bf16x8 qf0[4], qf1[4];
            { const bf16* qp = qkv + (size_t)(tok0 + l31) * DIN + (isA ? COL_QA + head * 64 : COL_QB + (head - 16) * 64) + 8 * hh;
#pragma unroll
                for (int ks = 0; ks < 4; ++ks) { qf0[ks] = __builtin_nontemporal_load((const bf16x8*)(qp + 16 * ks)); qf1[ks] = __builtin_nontemporal_load((const bf16x8*)(qp + (size_t)32 * DIN + 16 * ks)); }
                asm volatile("" :: "v"(qf0[0]), "v"(qf0[1]), "v"(qf0[2]), "v"(qf0[3]), "v"(qf1[0]), "v"(qf1[1]), "v"(qf1[2]), "v"(qf1[3])); }
            const bf16 *kb0, *vb0; int dmax; float m2a, la, nslope2 = 0.f, cb = 0.f;
            if (isA) { const size_t ho = ((size_t)(head >> 2) * NT + tok0) * 64; kb0 = (const bf16*)(kvh + KVH_KA) + ho; vb0 = (const bf16*)(kvh + KVH_VA) + ho; dmax = dmaxA;
                m2a = sinks[head] * LOG2E; la = hh == 0 ? 1.0f : 0.f; nslope2 = -__builtin_amdgcn_exp2f(-0.5f * (float)(head + 1)) * LOG2E; }
            else { const int hb = head - 16; const size_t ho = ((size_t)hb * NT + tok0) * 64; kb0 = (const bf16*)(kvh + KVH_KB) + ho; vb0 = (const bf16*)(kvh + KVH_VB) + ho; dmax = dmaxB; m2a = -1e30f; la = 0.f;
                for (int i = lane; i < 256; i += 64) { const int rel = i - 64; tbl[i] = relb[hb * 257 + (rel > 128 ? 128 : rel) + 128] * LOG2E; }
                cb = relb[hb * 257 + 256] * LOG2E; }
            float m2b = m2a, lb = la;
            const int nhead = head + 8; const bool nA = (it + 1) < 2;
            const size_t nho = ((size_t)(nA ? (nhead >> 2) : (nhead - 16)) * NT + tok0) * 64;
            const bf16* nkb0 = (const bf16*)(kvh + (nA ? KVH_KA : KVH_KB)) + nho; const bf16* nvb0 = (const bf16*)(kvh + (nA ? KVH_VA : KVH_VB)) + nho;
            f32x16 oa0, oa1, ob0, ob1;
#pragma unroll
            for (int r = 0; r < 16; ++r) { oa0[r] = 0.f; oa1[r] = 0.f; ob0[r] = 0.f; ob1[r] = 0.f; }
            for (int dd = 0; dd <= dmax; ++dd) {
                const bool first = (!isA) && dd == 0;
                unsigned klu = (unsigned)(__UINTPTR_TYPE__)kl; asm volatile("" : "+s"(klu));
                asm volatile("s_waitcnt vmcnt(8)" ::: "memory");
                f32x16 s0, s1;
                att_scores(s0, s1, qf0, kl + kro, hh, km, tbl, isA, dd, nslope2, cb, base0, first ? 0.f : m2a);
                att_softmax_pv<true>(s0, s1, oa0, oa1, m2a, la, vl, tr0, first);
                att_scores(s0, s1, qf1, kl + kro, hh, km, tbl, isA, dd, nslope2, cb, base0 + 32, first ? 0.f : m2b);
                __builtin_amdgcn_sched_barrier(0);
                if (dd < dmax) { const bf16* kp = kb0 - (size_t)(64 * (dd + 1)) * 64; ATT_DMAK(kp); }
                else if (it < 3) { ATT_DMAK(nkb0); }
                att_softmax_pv<false>(s0, s1, ob0, ob1, m2b, lb, vl, tr0, first);
                __builtin_amdgcn_sched_barrier(0);
                if (dd < dmax) { const bf16* vp = vb0 - (size_t)(64 * (dd + 1)) * 64; ATT_DMAV(vp); }
                else if (it < 3) { ATT_DMAV(nvb0); }
            }
#pragma unroll
            for (int qh = 0; qh < 2; ++qh) {
                f32x16& o0 = qh ? ob0 : oa0; f32x16& o1 = qh ? ob1 : oa1; float l = qh ? lb : la;
                { const auto rr = __builtin_amdgcn_permlane32_swap(__float_as_uint(l), __float_as_uint(l), false, false); l = __uint_as_float(rr[0]) + __uint_as_float(rr[1]); }
                const float inv = 1.0f / l; float ssq = 0.f;
#pragma unroll
                for (int r = 0; r < 16; ++r) { o0[r] *= inv; o1[r] *= inv; ssq += o0[r] * o0[r] + o1[r] * o1[r]; }
                ssq += __shfl_xor(ssq, 32);
                if (hh == 0) ssqp[head * 64 + 32 * qh + l31] = ssq;
                unsigned char* op = O + (size_t)(tok0 + 32 * qh + l31) * DM + head * 64 + 4 * hh;
#pragma unroll
                for (int r4 = 0; r4 < 4; ++r4) { *(unsigned*)(op + 8 * r4) = cvt4_fp8(o0[4 * r4] * F8_SO, o0[4 * r4 + 1] * F8_SO, o0[4 * r4 + 2] * F8_SO, o0[4 * r4 + 3] * F8_SO);
                    *(unsigned*)(op + 32 + 8 * r4) = cvt4_fp8(o1[4 * r4] * F8_SO, o1[4 * r4 + 1] * F8_SO, o1[4 * r4 + 2] * F8_SO, o1[4 * r4 + 3] * F8_SO); }
            }
        }
        __syncthreads();
        if (tid < 128) { const int g = tid >> 6, q = tid & 63; float sacc = 0.f;
#pragma unroll
            for (int h = 0; h < 16; ++h) sacc += ssqp[(16 * g + h) * 64 + q];
            float* SSQ = (float*)(a.ws + WS_SSQ); SSQ[(size_t)(tok0 + q) * 2 + g] = sacc; }
        __syncthreads();
    }
}

constexpr int P5_ROWB = 528;
__device__ __forceinline__ void p5_norm_router(const Ctx& a, LAS unsigned char* lds, int tid, int lane, int wave) {
    const bf16* x1 = (const bf16*)(a.ws + WS_X1); const float* mod = (const float*)(a.ws + WS_MOD); unsigned char* H = a.ws + WS_H;
    const float* aux = (const float*)(a.ws + WS_AUX);
    const bf16* wrhi = (const bf16*)(a.ws + WS_WRT); const bf16* wrlo = wrhi + 48 * 2048;
    unsigned char* rt = a.ws + WS_ROUTE;
    int* tok_e = (int*)(rt + RT_TOKE); float* tok_w = (float*)(rt + RT_TOKW); int* tok_rank = (int*)(rt + RT_RANK); int* cntWG = (int*)(rt + RT_CNT);
    constexpr int TILE_B = 16 * P5_ROWB, WR_B = 48 * P5_ROWB;
    const int pairi = wave >> 1, odd = wave & 1;
    LAS unsigned char* uh = lds + pairi * (2 * TILE_B);
    LAS unsigned char* ul = uh + TILE_B;
    LAS unsigned char* wh = lds + 4 * 2 * TILE_B;
    LAS unsigned char* wl = wh + WR_B;
    LAS float* up = (LAS float*)(lds + 4 * 2 * TILE_B + 2 * WR_B);
    LAS float* sp = up + 64 * 48;
    LAS float* lg = sp + 64;
    LAS float* rsd = lg + 64 * 48;
    static_assert(4 * 2 * TILE_B + 2 * WR_B + (64 * 48 + 64 + 64 * 48 + 64) * 4 <= MISC_OFF, "P5 LDS map");
    const int tr = lane & 15, kq = lane >> 4;
    const int hrow = lane >> 5, hl = lane & 31;
    for (int blk = blockIdx.x; blk < 256; blk += gridDim.x) {
        const int t0 = blk * 64 + pairi * 16, b = blk >> 6;
        const bf16* xw = x1 + (size_t)(t0 + 8 * odd + hrow) * DM + 8 * hl;
        const float* ap = aux + 1024 + b * DM + 8 * hl;
        const float* shp = mod + (size_t)b * 16384 + 6144 + 8 * hl; unsigned char* hwp = H + (size_t)(t0 + 8 * odd + hrow) * DM + 8 * hl;
        const int wrow0 = wave * 6;
        if (tid < 64) {
            const f32x4* pr = (const f32x4*)((const float*)(a.ws + WS_RSS) + (size_t)(blk * 64 + tid) * 64); f32x4 acc4 = pr[0];
#pragma unroll
            for (int i = 1; i < 16; ++i) acc4 = acc4 + pr[i];
            rsd[tid] = __builtin_amdgcn_rsqf(((acc4[0] + acc4[1]) + (acc4[2] + acc4[3])) * (1.0f / DM) + EPS); }
        __syncthreads();
        {
            f32x4 acc[2];
            acc[0] = (f32x4){0.f, 0.f, 0.f, 0.f}; acc[1] = (f32x4){0.f, 0.f, 0.f, 0.f};
            u32x4 xv[4], wv[6];
#pragma unroll
            for (int i = 0; i < 4; ++i) xv[i] = __builtin_nontemporal_load((const u32x4*)(xw + (size_t)(2 * i) * DM));
#pragma unroll
            for (int i = 0; i < 6; ++i) { const int r = 2 * (wrow0 + i) + hrow; wv[i] = *(const u32x4*)((r < 48 ? wrhi + (size_t)r * 2048 : wrlo + (size_t)(r - 48) * 2048) + 8 * hl); }
            for (int c4 = 0; c4 < 8; ++c4) {
                const f32x4 a0 = *(const f32x4*)(ap + 256 * c4), a1 = *(const f32x4*)(ap + 256 * c4 + 4), sh0 = *(const f32x4*)(shp + 256 * c4), sh1 = *(const f32x4*)(shp + 256 * c4 + 4);
                __syncthreads();
#pragma unroll
                for (int i = 0; i < 4; ++i) { const u32x4 v = xv[i]; const int r = 8 * odd + 2 * i + hrow; const float rs = rsd[pairi * 16 + r];
                    const f32x4 f0 = {bf_lo(v.x), bf_hi(v.x), bf_lo(v.y), bf_hi(v.y)}, f1 = {bf_lo(v.z), bf_hi(v.z), bf_lo(v.w), bf_hi(v.w)};
                    const f32x4 u0 = f0 * a0, u1 = f1 * a1; u32x4 hi, lo;
                    { const f32x4 h0 = (u0 * rs + sh0) * F8_SH, h1 = (u1 * rs + sh1) * F8_SH; u32x2 hw; hw.x = cvt4_fp8(h0[0], h0[1], h0[2], h0[3]); hw.y = cvt4_fp8(h1[0], h1[1], h1[2], h1[3]);
                      *(u32x2*)(hwp + (size_t)(2 * i) * DM + 256 * c4) = hw; }
                    hi.x = cvtpk(u0[0], u0[1]); hi.y = cvtpk(u0[2], u0[3]); hi.z = cvtpk(u1[0], u1[1]); hi.w = cvtpk(u1[2], u1[3]);
                    lo.x = cvtpk(u0[0] - bf_lo(hi.x), u0[1] - bf_hi(hi.x)); lo.y = cvtpk(u0[2] - bf_lo(hi.y), u0[3] - bf_hi(hi.y));
                    lo.z = cvtpk(u1[0] - bf_lo(hi.z), u1[1] - bf_hi(hi.z)); lo.w = cvtpk(u1[2] - bf_lo(hi.w), u1[3] - bf_hi(hi.w));
                    *(LAS u32x4*)(uh + r * P5_ROWB + 16 * hl) = hi; *(LAS u32x4*)(ul + r * P5_ROWB + 16 * hl) = lo; }
#pragma unroll
                for (int i = 0; i < 6; ++i) { const int r = 2 * (wrow0 + i) + hrow; *(LAS u32x4*)(wh + r * P5_ROWB + 16 * hl) = wv[i]; }
                if (c4 < 7) {
#pragma unroll
                    for (int i = 0; i < 4; ++i) xv[i] = __builtin_nontemporal_load((const u32x4*)(xw + (size_t)(2 * i) * DM + 256 * (c4 + 1)));
#pragma unroll
                    for (int i = 0; i < 6; ++i) { const int r = 2 * (wrow0 + i) + hrow; wv[i] = *(const u32x4*)((r < 48 ? wrhi + (size_t)r * 2048 : wrlo + (size_t)(r - 48) * 2048) + 256 * (c4 + 1) + 8 * hl); } }
                __syncthreads();
#pragma unroll 2
                for (int kk = 0; kk < 8; ++kk) {
                    const bf16x8 ahi = *(const LAS bf16x8*)(uh + tr * P5_ROWB + 64 * kk + 16 * kq), alo = *(const LAS bf16x8*)(ul + tr * P5_ROWB + 64 * kk + 16 * kq);
                    if (!odd) {
#pragma unroll
                        for (int c = 0; c < 2; ++c) { const bf16x8 bhi = *(const LAS bf16x8*)(wh + (16 * c + tr) * P5_ROWB + 64 * kk + 16 * kq), blo = *(const LAS bf16x8*)(wl + (16 * c + tr) * P5_ROWB + 64 * kk + 16 * kq);
                            acc[c] = __builtin_amdgcn_mfma_f32_16x16x32_bf16(ahi, bhi, acc[c], 0, 0, 0);
                            acc[c] = __builtin_amdgcn_mfma_f32_16x16x32_bf16(ahi, blo, acc[c], 0, 0, 0);
                            acc[c] = __builtin_amdgcn_mfma_f32_16x16x32_bf16(alo, bhi, acc[c], 0, 0, 0); }
                    } else { const bf16x8 bhi = *(const LAS bf16x8*)(wh + (32 + tr) * P5_ROWB + 64 * kk + 16 * kq), blo = *(const LAS bf16x8*)(wl + (32 + tr) * P5_ROWB + 64 * kk + 16 * kq);
                        acc[0] = __builtin_amdgcn_mfma_f32_16x16x32_bf16(ahi, bhi, acc[0], 0, 0, 0);
                        acc[0] = __builtin_amdgcn_mfma_f32_16x16x32_bf16(ahi, blo, acc[0], 0, 0, 0);
                        acc[0] = __builtin_amdgcn_mfma_f32_16x16x32_bf16(alo, bhi, acc[0], 0, 0, 0); }
                }
            }
            if (!odd) {
#pragma unroll
                for (int c = 0; c < 2; ++c)
#pragma unroll
                    for (int r = 0; r < 4; ++r) up[(pairi * 16 + 4 * kq + r) * 48 + 16 * c + tr] = acc[c][r];
            } else {
#pragma unroll
                for (int r = 0; r < 4; ++r) up[(pairi * 16 + 4 * kq + r) * 48 + 32 + tr] = acc[0][r];
            }
        }
        __syncthreads();
        for (int i = tid; i < 64 * 48; i += 512) { const int tok = i / 48, c = i - tok * 48; lg[i] = rsd[tok] * up[i] + aux[b * 48 + c]; }
        __syncthreads();
        if (tid < 64) {
            const int tt = blk * 64 + tid; const LAS float* L = lg + tid * 48;
            float gl[4]; int gi = 0;
#pragma unroll
            for (int j = 0; j < 4; ++j) gl[j] = L[j];
            float gm = gl[0];
#pragma unroll
            for (int j = 1; j < 4; ++j) if (gl[j] > gm) { gm = gl[j]; gi = j; }
            float den = 0.f;
#pragma unroll
            for (int j = 0; j < 4; ++j) den += __expf(gl[j] - gm);
            const float pg = 1.0f / den;
            float el[8];
#pragma unroll
            for (int i = 0; i < 8; ++i) el[i] = L[4 + 8 * gi + i];
            int i1 = 0; float v1 = el[0];
#pragma unroll
            for (int i = 1; i < 8; ++i) if (el[i] > v1) { v1 = el[i]; i1 = i; }
            int i2 = -1; float v2 = -3.0e38f;
#pragma unroll
            for (int i = 0; i < 8; ++i) if (i != i1 && el[i] > v2) { v2 = el[i]; i2 = i; }
            const float ex = __expf(v2 - v1), w1 = pg / (1.0f + ex), w2 = pg * ex / (1.0f + ex);
            const int e1 = gi * 8 + i1, e2 = gi * 8 + i2;
            const unsigned long long lt = (1ull << lane) - 1ull;
            int r1 = 0, r2 = 0, mycnt = 0;
            for (int e = 0; e < NEXP; ++e) { const unsigned long long m1 = __ballot(e1 == e), m2 = __ballot(e2 == e); const int c1 = __popcll(m1);
                if (e1 == e) r1 = __popcll(m1 & lt); if (e2 == e) r2 = c1 + __popcll(m2 & lt); if (lane == e) mycnt = c1 + __popcll(m2); }
            tok_e[2 * tt] = e1; tok_e[2 * tt + 1] = e2; tok_w[2 * tt] = w1; tok_w[2 * tt + 1] = w2; tok_rank[2 * tt] = r1; tok_rank[2 * tt + 1] = r2;
            if (lane < NEXP) cntWG[blk * NEXP + lane] = mycnt;
        }
        __syncthreads();
    }
}

__device__ __forceinline__ void p6_slots(const Ctx& a, LAS unsigned char* lds, int tid) {
    unsigned char* rt = a.ws + WS_ROUTE;
    const int* tok_e = (const int*)(rt + RT_TOKE); const int* tok_rank = (const int*)(rt + RT_RANK); int* tok_slot = (int*)(rt + RT_SLOT); const int* cntWG = (const int*)(rt + RT_CNT);
    int* rowidx = (int*)(rt + RT_ROWIDX); int* tile_exp = (int*)(rt + RT_TILEEXP); int* ntiles = (int*)(rt + RT_NTILES);
    LAS int* ptot = (LAS int*)lds;
    LAS int* ppre = ptot + 512;
    LAS int* tot = ppre + 512;
    LAS int* pre = tot + 32;
    LAS int* sb = pre + 32;
    for (int blk = blockIdx.x; blk < 256; blk += gridDim.x) {
        { const int e = tid & 31, part = tid >> 5; int st = 0, sp = 0;
            for (int w = part * 16; w < part * 16 + 16; ++w) { const int c = cntWG[w * NEXP + e]; st += c; if (w < blk) sp += c; }
            ptot[part * 32 + e] = st; ppre[part * 32 + e] = sp; }
        __syncthreads();
        if (tid < 32) { int st = 0, sp = 0;
#pragma unroll
            for (int p = 0; p < 16; ++p) { st += ptot[p * 32 + tid]; sp += ppre[p * 32 + tid]; }
            tot[tid] = st; pre[tid] = sp; }
        __syncthreads();
        if (tid == 0) { int s = 0; for (int e = 0; e < NEXP; ++e) { sb[e] = s; s += ((tot[e] + 255) >> 8) << 8; } sb[NEXP] = s; }
        __syncthreads();
        if (tid < 128) { const int tk = blk * 64 + (tid >> 1), j = tid & 1; const int e = tok_e[2 * tk + j]; const int slot = sb[e] + pre[e] + tok_rank[2 * tk + j];
            tok_slot[2 * tk + j] = slot; rowidx[slot] = tk; }
        if (blk < NEXP) { const int e = blk, s0 = sb[e] + tot[e], s1 = sb[e + 1];
            for (int s = s0 + tid; s < s1; s += 512) rowidx[s] = 0;
            for (int g = (sb[e] >> 8) + tid; g < (sb[e + 1] >> 8); g += 512) tile_exp[g] = e; }
        if (blk == 0 && tid == 0) ntiles[0] = sb[NEXP] >> 8;
        if (blk == 0 && tid <= NEXP) ((int*)(rt + RT_TSTART))[tid] = sb[tid] >> 8;
        __syncthreads();
    }
}

__device__ __forceinline__ void p9_final(const Ctx& a, int lane, int wave) {
    const bf16* X = (const bf16*)(a.ws + WS_X1); float* OUT = a.out; const float* gf = a.in[I_GFIN]; const float* mod = (const float*)(a.ws + WS_MOD); const unsigned char* Y = a.ws + WS_Y;
    unsigned char* rt = a.ws + WS_ROUTE; const int* tok_slot = (const int*)(rt + RT_SLOT); const float* tok_w = (const float*)(rt + RT_TOKW);
    const int gw = blockIdx.x * 8 + wave, NGW = gridDim.x * 8;
    for (int grp = gw; grp < NT / 8; grp += NGW) {
        const int row0 = grp * 8, b = row0 >> 12;
        f32x4 A[8], Bv[8], G2[8];
#pragma unroll
        for (int j = 0; j < 8; ++j) { const int k = 4 * lane + 256 * j; const f32x4 gg = *(const f32x4*)(gf + k), sc = *(const f32x4*)(mod + (size_t)b * 16384 + 12288 + 2048 + k);
            A[j] = gg * (1.0f + sc); Bv[j] = *(const f32x4*)(mod + (size_t)b * 16384 + 12288 + k); G2[j] = *(const f32x4*)(mod + (size_t)b * 16384 + 10240 + k); }
        const int lr = lane & 7; const int2 sl = *(const int2*)(tok_slot + 2 * (row0 + lr)); const f32x2_t wl = *(const f32x2_t*)(tok_w + 2 * (row0 + lr));
        for (int r = 0; r < 8; r += 2) {
            u32x2 xb[2][8]; unsigned ya[2][8], yb[2][8]; float w1[2], w2[2];
#pragma unroll
            for (int h = 0; h < 2; ++h) { const int t = row0 + r + h;
                const int s1 = __builtin_amdgcn_readlane(sl.x, r + h), s2 = __builtin_amdgcn_readlane(sl.y, r + h);
                w1[h] = __uint_as_float(__builtin_amdgcn_readlane(__float_as_uint(wl.x), r + h)) * (1.0f / F8_SY); w2[h] = __uint_as_float(__builtin_amdgcn_readlane(__float_as_uint(wl.y), r + h)) * (1.0f / F8_SY);
                const bf16* xr = X + (size_t)t * DM + 4 * lane; const unsigned char* y1 = Y + (size_t)s1 * DM + 4 * lane; const unsigned char* y2 = Y + (size_t)s2 * DM + 4 * lane;
#pragma unroll
                for (int j = 0; j < 8; ++j) { xb[h][j] = __builtin_nontemporal_load((const u32x2*)(xr + 256 * j)); ya[h][j] = __builtin_nontemporal_load((const unsigned*)(y1 + 256 * j)); yb[h][j] = __builtin_nontemporal_load((const unsigned*)(y2 + 256 * j)); } }
#pragma unroll
            for (int h = 0; h < 2; ++h) { float* outr = OUT + (size_t)(row0 + r + h) * DM + 4 * lane; f32x4 v[8]; float s = 0.f;
#pragma unroll
                for (int j = 0; j < 8; ++j) { const u32x2 x2 = xb[h][j]; const f32x4 xv = {bf_lo(x2.x), bf_hi(x2.x), bf_lo(x2.y), bf_hi(x2.y)};
                    const f32x2_t p0 = __builtin_amdgcn_cvt_pk_f32_fp8((int)ya[h][j], false), p1 = __builtin_amdgcn_cvt_pk_f32_fp8((int)ya[h][j], true), q0 = __builtin_amdgcn_cvt_pk_f32_fp8((int)yb[h][j], false), q1 = __builtin_amdgcn_cvt_pk_f32_fp8((int)yb[h][j], true);
                    f32x4 yv; yv[0] = w1[h] * p0[0] + w2[h] * q0[0]; yv[1] = w1[h] * p0[1] + w2[h] * q0[1]; yv[2] = w1[h] * p1[0] + w2[h] * q1[0]; yv[3] = w1[h] * p1[1] + w2[h] * q1[1];
                    v[j] = xv + G2[j] * yv; s += (v[j][0] * v[j][0] + v[j][1] * v[j][1]) + (v[j][2] * v[j][2] + v[j][3] * v[j][3]); }
                const float rstd = __builtin_amdgcn_rsqf(wave_sum(s) * (1.0f / DM) + EPS);
#pragma unroll
                for (int j = 0; j < 8; ++j) __builtin_nontemporal_store(v[j] * rstd * A[j] + Bv[j], (f32x4*)(outr + 256 * j)); }
        }
    }
}

constexpr int NPH = 10;
__global__ void __launch_bounds__(512, 2) hybrid_fwd(Args kargs) {
    extern __shared__ __attribute__((aligned(16))) unsigned char lds_raw[];
    LAS unsigned char* lds = (LAS unsigned char*)lds_raw;
    const int tid = threadIdx.x, lane = tid & 63, wave = __builtin_amdgcn_readfirstlane(tid >> 6);
    volatile LAS unsigned* MISC = (volatile LAS unsigned*)(lds + MISC_OFF);
    if (tid < 4) MISC[tid] = 0u;
    __syncthreads();
    const int lo = kargs.ph_lo, hi = kargs.ph_hi;
    Ctx args; args.out = kargs.out; args.ws = kargs.ws;
    XcdBarrier bar; bar.bar = (unsigned*)(args.ws + WS_CTL); bar.x = 0; bar.st = nullptr;
    if (hi - lo > 1) bar = xcd_barrier_post((unsigned*)(args.ws + WS_CTL), MISC);
#define IN(k) (lo <= (k) && (k) < hi)
#define REPS(k) (((REPEAT_MASK >> (k)) & 1) ? 2 : 1)
#define SEAM(k) do { if (IN(k) && IN((k) + 1)) xcd_barrier(bar); } while (0)

    if (IN(0)) for (int rep = 0; rep < REPS(0); ++rep) { p0_mod(args, lds, tid, lane, wave); p0_convert(args, lds, tid, lane, wave); __syncthreads(); }
    SEAM(0);
    if (IN(1)) for (int rep = 0; rep < REPS(1); ++rep) { p1_norm(args, lane, wave); }
    SEAM(1);
    if (IN(2)) for (int rep = 0; rep < REPS(2); ++rep) {
        pg8::DenseOrder S; S.init(args.ws + WS_H, args.ws + WS_WIN, NT, DIN, DM, (int)gridDim.x, (int)blockIdx.x);
        pg8::EpiQKV E{(bf16*)(args.ws + WS_QKV), (bf16*)(args.ws + WS_KVH)};
        { const int G = (int)gridDim.x, rem = S.nwg % G;
          if (rem != 0 && (int)blockIdx.x >= rem) convert_items(args, lds, lane, wave, CV_UP_TAIL, CV_DN0, ((int)blockIdx.x - rem) * 8 + wave, (G - rem) * 8);
          else if (rem == 0) convert_items(args, lds, lane, wave, CV_UP_TAIL, CV_DN0, (int)blockIdx.x * 8 + wave, G * 8);
          __syncthreads(); }
        pg8::gemm_phase<pg8::EpiQKV, pg8::DenseOrder, false>(lds, DM, S, E);
    }
    SEAM(2);
    if (IN(3)) for (int rep = 0; rep < REPS(3); ++rep) { p3_attn(args, lds, tid, lane, wave); }
    SEAM(3);
    if (IN(4)) for (int rep = 0; rep < REPS(4); ++rep) {
        pg8::DenseOrder S; S.init(args.ws + WS_O, args.ws + WS_WOUT, NT, DM, DM / 2, (int)gridDim.x, (int)blockIdx.x);
        pg8::EpiRes E{args.in[I_X], (bf16*)(args.ws + WS_X1), (const float*)(args.ws + WS_MOD), (const float*)(args.ws + WS_SSQ), (float*)(args.ws + WS_RSS)};
        { const int G = (int)gridDim.x; if ((int)blockIdx.x >= G / 2) convert_items(args, lds, lane, wave, CV_G_P4, CV_UP0, ((int)blockIdx.x - G / 2) * 8 + wave, (G - G / 2) * 8); __syncthreads(); }
        {
            LAS float* tab = (LAS float*)(lds + pg8::EpiRes::TAB_OFF); const float* SSQ = (const float*)(args.ws + WS_SSQ); pg8::Unit u;
            for (int i = 0; i < 8 && S.next(i, u); ++i)
                if (tid < 256) { const float qa = SSQ[(size_t)(u.pm * 256 + tid) * 2], qb = SSQ[(size_t)(u.pm * 256 + tid) * 2 + 1];
                    const float rA = __builtin_amdgcn_rsqf(qa * (1.0f / 1024.0f) + EPS), rB = __builtin_amdgcn_rsqf(qb * (1.0f / 1024.0f) + EPS);
                    tab[(i * 256 + tid) * 2] = rA / rB; tab[(i * 256 + tid) * 2 + 1] = rB * (1.0f / (F8_SO * F8_SWO)); }
            __syncthreads();
        }
        pg8::gemm_phase<pg8::EpiRes, pg8::DenseOrder, false, true>(lds, DM / 2, S, E);
    }
    SEAM(4);
    if (IN(5)) for (int rep = 0; rep < REPS(5); ++rep) { p5_norm_router(args, lds, tid, lane, wave); }
    SEAM(5);
    if (IN(6)) { p6_slots(args, lds, tid); }
    SEAM(6);
    if (IN(7)) for (int rep = 0; rep < REPS(7); ++rep) {
        unsigned char* rt = args.ws + WS_ROUTE;
        pg8::GroupedOrder S; S.A = (const char*)(args.ws + WS_H); S.Bt = (const char*)(args.ws + WS_WGU); S.estride = (size_t)1024 * DM; S.K = DM / 2;
        S.rowidx = (const int*)(rt + RT_ROWIDX);
        const int ntiles = *(const int*)(rt + RT_NTILES);
        pg8::EpiGU E{args.ws + WS_ACT};
        { const int G = (int)gridDim.x; const int* ts = (const int*)(rt + RT_TSTART);
          const int nlab = (G % 8 == 0) ? 8 : 1, Gx = G / nlab, myx = nlab == 8 ? ((int)blockIdx.x & 7) : 0, myj = nlab == 8 ? ((int)blockIdx.x >> 3) : (int)blockIdx.x;
          int numax = 0;
          for (int x = 0; x < nlab; ++x) { int nu = 0; for (int e = x; e < NEXP; e += nlab) nu += (ts[e + 1] - ts[e]) * 4; numax = nu > numax ? nu : numax; }
          const int maxc = (numax + Gx - 1) / Gx;
          int nconv = 0, myidx = -1;
          for (int x = 0; x < nlab; ++x) { int nu = 0; for (int e = x; e < NEXP; e += nlab) nu += (ts[e + 1] - ts[e]) * 4;
              int nfull = nu - Gx * (maxc - 1); nfull = nfull < 0 ? 0 : (nfull > Gx ? Gx : nfull);
              if (x == myx && myj >= nfull) myidx = nconv + (myj - nfull);
              nconv += Gx - nfull; }
          if (nconv == 0) convert_items(args, lds, lane, wave, CV_DN_TAIL, CV_ALL, (int)blockIdx.x * 8 + wave, G * 8);
          else if (myidx >= 0) convert_items(args, lds, lane, wave, CV_DN_TAIL, CV_ALL, myidx * 8 + wave, nconv * 8);
          __syncthreads(); }
        S.build(lds, (const int*)(rt + RT_TSTART), 4, (int)gridDim.x, (int)blockIdx.x);
        pg8::gemm_phase<pg8::EpiGU, pg8::GroupedOrder, true, true>(lds, DM / 2, S, E);
    }
    SEAM(7);
    if (IN(8)) for (int rep = 0; rep < REPS(8); ++rep) {
        unsigned char* rt = args.ws + WS_ROUTE;
        pg8::GroupedOrder S; S.A = (const char*)(args.ws + WS_ACT); S.Bt = (const char*)(args.ws + WS_WD); S.estride = (size_t)DM * DE; S.K = DE / 2;
        S.rowidx = nullptr; S.build(lds, (const int*)(rt + RT_TSTART), 8, (int)gridDim.x, (int)blockIdx.x);
        pg8::EpiY E{args.ws + WS_Y};
        pg8::gemm_phase<pg8::EpiY, pg8::GroupedOrder, false, true>(lds, DE / 2, S, E);
    }
    SEAM(8);
    if (IN(9)) { p9_final(args, lane, wave); }
#undef IN
#undef SEAM
}

extern "C" void kernel_launch(void* const* d_in, const int* in_sizes, int n_in, void* d_out, int out_size, void* d_ws, size_t ws_size, hipStream_t stream) {
    static int grid = 0;
    if (grid == 0) {
        if (n_in != 22 || out_size != NT * DM || ws_size < WS_END) { fprintf(stderr, "kernel_launch: unexpected shapes (n_in %d, out %d, ws %zu)\n", n_in, out_size, ws_size); grid = -1; return; }
        int dev = 0, cus = 0, per_cu = 0;
        if (hipGetDevice(&dev) != hipSuccess || hipDeviceGetAttribute(&cus, hipDeviceAttributeMultiprocessorCount, dev) != hipSuccess) { grid = -1; return; }
        if (hipFuncSetAttribute((const void*)hybrid_fwd, hipFuncAttributeMaxDynamicSharedMemorySize, LDS_BYTES) != hipSuccess) { fprintf(stderr, "kernel_launch: hipFuncSetAttribute failed\n"); grid = -1; return; }
        if (hipOccupancyMaxActiveBlocksPerMultiprocessor(&per_cu, (const void*)hybrid_fwd, 512, LDS_BYTES) != hipSuccess || per_cu < 1) { fprintf(stderr, "kernel_launch: occupancy query says %d\n", per_cu); }
        (void)hipGetLastError();
        grid = cus;
    }
    if (grid < 0) return;
    (void)hipMemsetAsync((char*)d_ws + WS_CTL, 0, CTL_ZERO_BYTES, stream);
    Args a{};
    for (int i = 0; i < 22; ++i) a.in[i] = (const float*)d_in[i];
    a.out = (float*)d_out; a.ws = (unsigned char*)d_ws;
#if MK_PER_PHASE
    for (int p = 0; p < NPH; ++p) { a.ph_lo = p; a.ph_hi = p + 1; hipLaunchKernelGGL(hybrid_fwd, dim3(grid), dim3(512), LDS_BYTES, stream, a); }
#else
    if (PROBE_EXTRA_PHASE >= 0) {
        a.ph_lo = 0; a.ph_hi = PROBE_EXTRA_PHASE + 1; hipLaunchKernelGGL(hybrid_fwd, dim3(grid), dim3(512), LDS_BYTES, stream, a);
        (void)hipMemsetAsync((char*)d_ws + WS_CTL, 0, CTL_ZERO_BYTES, stream);
        a.ph_lo = PROBE_EXTRA_PHASE; a.ph_hi = PROBE_EXTRA_PHASE + 1; hipLaunchKernelGGL(hybrid_fwd, dim3(grid), dim3(512), LDS_BYTES, stream, a);
        if (PROBE_EXTRA_PHASE + 1 < NPH) { a.ph_lo = PROBE_EXTRA_PHASE + 1; a.ph_hi = NPH; hipLaunchKernelGGL(hybrid_fwd, dim3(grid), dim3(512), LDS_BYTES, stream, a); }
    } else { a.ph_lo = 0; a.ph_hi = NPH; hipLaunchKernelGGL(hybrid_fwd, dim3(grid), dim3(512), LDS_BYTES, stream, a); }
#endif
}
```

```cpp
#include <hip/hip_runtime.h>
#include <cstdio>
#include <cstdint>

#ifndef MK_PER_PHASE
#define MK_PER_PHASE 0
#endif

#ifndef PROBE_EXTRA_PHASE
#define PROBE_EXTRA_PHASE -1
#endif
#ifndef EPI_REPS
#define EPI_REPS 1
#endif
#ifndef REPEAT_MASK
#define REPEAT_MASK 0
#endif
#define GAS __attribute__((address_space(1)))
#define LAS __attribute__((address_space(3)))
typedef unsigned short bf16;
typedef short bf16x8 __attribute__((ext_vector_type(8)));
typedef short s16x4 __attribute__((ext_vector_type(4)));
typedef float f32x4 __attribute__((ext_vector_type(4)));
typedef float f32x16 __attribute__((ext_vector_type(16)));
typedef unsigned u32x4 __attribute__((ext_vector_type(4)));
typedef unsigned u32x2 __attribute__((ext_vector_type(2)));
typedef float f32x2_t __attribute__((ext_vector_type(2)));
typedef __bf16 bf16x2_t __attribute__((ext_vector_type(2)));

constexpr int DM = 2048, NB = 4, SEQ = 4096, NT = NB * SEQ, DIN = 4608, NEXP = 32, DE = 512;
constexpr int COL_QA = 0, COL_KA = 1024, COL_VA = 1280, COL_QB = 1536, COL_KB = 2560, COL_VB = 3584;
constexpr int MAXTILES = 160, MAXSLOTS = MAXTILES * 256;
constexpr float EPS = 1e-6f, LOG2E = 1.4426950408889634f;

constexpr size_t MiB = 1u << 20;
constexpr size_t WS_CTL = 0, CTL_ZERO_BYTES = 16384;
constexpr size_t WS_MOD = 1 * MiB;
constexpr size_t WS_ROUTE = 2 * MiB;
constexpr size_t RT_TOKE = 0, RT_TOKW = 131072, RT_RANK = 262144, RT_SLOT = 393216, RT_CNT = 524288, RT_ROWIDX = 557056, RT_TILEEXP = 720896, RT_NTILES = 724992, RT_TSTART = 729088;
constexpr size_t WS_AUX = 3 * MiB;
constexpr size_t WS_SSQ = 3 * MiB + 512 * 1024;
constexpr size_t WS_WRT = 4 * MiB;
constexpr size_t WS_WIN = 5 * MiB;
constexpr size_t WS_WOUT = 23 * MiB;
constexpr size_t WS_WGU = 32 * MiB;
constexpr size_t WS_WD = 160 * MiB;
constexpr size_t WS_H = 224 * MiB;
constexpr size_t WS_QKV = 288 * MiB;
constexpr size_t WS_O = 432 * MiB;
constexpr size_t WS_Y = 288 * MiB;
constexpr size_t WS_ACT = 448 * MiB;
constexpr size_t WS_X1 = 496 * MiB;
constexpr size_t WS_KVH = 560 * MiB;
constexpr size_t KVH_KA = 0, KVH_VA = 8 * MiB, KVH_KB = 16 * MiB, KVH_VB = 48 * MiB;
constexpr size_t WS_RSS = 640 * MiB;
constexpr size_t WS_END = 644 * MiB;

constexpr int RING_BYTES = 131072;
constexpr int MISC_OFF = 151552;
constexpr int LDS_BYTES = 155648;

__device__ __forceinline__ unsigned cvtpk(float lo, float hi) { f32x2_t v = {lo, hi}; bf16x2_t b = __builtin_convertvector(v, bf16x2_t); return __builtin_bit_cast(unsigned, b); }
__device__ __forceinline__ unsigned cvt4_fp8(float a, float b, float c, float d) {
    a = __builtin_fminf(__builtin_fmaxf(a, -448.f), 448.f); b = __builtin_fminf(__builtin_fmaxf(b, -448.f), 448.f);
    c = __builtin_fminf(__builtin_fmaxf(c, -448.f), 448.f); d = __builtin_fminf(__builtin_fmaxf(d, -448.f), 448.f);
    int r = 0; r = __builtin_amdgcn_cvt_pk_fp8_f32(a, b, r, false); r = __builtin_amdgcn_cvt_pk_fp8_f32(c, d, r, true); return (unsigned)r; }
constexpr float F8_SH = 8.0f, F8_SWGU = 1024.0f, F8_SACT = 8.0f, F8_SWD = 512.0f, F8_SY = 32.0f, F8_SO = 64.0f, F8_SWO = 1024.0f;
__device__ __forceinline__ float bf_lo(unsigned u) { return __uint_as_float(u << 16); }
__device__ __forceinline__ float bf_hi(unsigned u) { return __uint_as_float(u & 0xffff0000u); }
__device__ __forceinline__ float wave_sum(float v) {
#pragma unroll
    for (int o = 1; o < 64; o <<= 1) v += __shfl_xor(v, o);
    return v;
}
#define LDS_WAIT() asm volatile("s_waitcnt lgkmcnt(0)" ::: "memory")

#define XB_TMO      128
#define XB_XCNT(j)  (256  + 64 * (j))
#define XB_XSUB(j)  (1280 + 64 * (j))
#define XB_XGEN(j)  (2304 + 64 * (j))
#define XB_TOP      3328
#define XB_TOPGEN   3392
#define XCD_BAR_WORDS 3456
#define XB_SPIN_CAP (1u << 18)

__device__ __forceinline__ unsigned xb_ld(unsigned* p)              { return __hip_atomic_load(p, __ATOMIC_RELAXED, __HIP_MEMORY_SCOPE_AGENT); }
__device__ __forceinline__ unsigned xb_add(unsigned* p, unsigned v) { return __hip_atomic_fetch_add(p, v, __ATOMIC_RELAXED, __HIP_MEMORY_SCOPE_AGENT); }
__device__ __forceinline__ unsigned xb_xcc_id() { return (unsigned)__builtin_amdgcn_s_getreg((3 << 11) | 20) & 0xFu; }
#define XB_SPIN(cond, bar) do { unsigned _sp = 0; while (cond) { __builtin_amdgcn_s_sleep(1); \
    if ((++_sp & 255u) == 0u) { if (xb_ld(&(bar)[XB_TMO])) break; if (_sp > XB_SPIN_CAP) { atomicAdd(&(bar)[XB_TMO], 1u); break; } } } } while (0)

struct XcdBarrier { unsigned* bar; unsigned x; volatile LAS unsigned* st; };

__device__ __forceinline__ XcdBarrier xcd_barrier_post(unsigned* bar, volatile LAS unsigned* st) {
    XcdBarrier b; b.bar = bar; b.x = xb_xcc_id(); b.st = st;
    if (threadIdx.x == 0) (void)xb_add(&bar[XB_XCNT(b.x)], 1u);
    return b;
}
__device__ __forceinline__ void xcd_barrier_complete(unsigned* bar, unsigned x, unsigned& nloc, unsigned& nx) {
    const unsigned G = gridDim.x * gridDim.y * gridDim.z;
    unsigned sum, cnt, mine, sp = 0u;
    for (;;) {
        sum = 0u; cnt = 0u; mine = 0u;
#pragma unroll
        for (unsigned j = 0; j < 16; ++j) { const unsigned c = xb_ld(&bar[XB_XCNT(j)]); sum += c; cnt += (c > 0u) ? 1u : 0u; mine = (j == x) ? c : mine; }
        if (sum == G) break;
        __builtin_amdgcn_s_sleep(1);
        if ((++sp & 255u) == 0u) { if (xb_ld(&bar[XB_TMO])) break; if (sp > XB_SPIN_CAP) { atomicAdd(&bar[XB_TMO], 1u); break; } }
    }
    nloc = mine > 0u ? mine : 1u; nx = cnt > 0u ? cnt : 1u;
}
__device__ __forceinline__ void xcd_barrier(const XcdBarrier& b) {
    asm volatile("s_waitcnt vmcnt(0)" ::: "memory");
    __syncthreads();
    if (threadIdx.x == 0) {
        unsigned* bar = b.bar;
        __builtin_amdgcn_s_waitcnt(0);
        unsigned nloc = b.st[0], nx = b.st[1];
        if (nloc == 0u) { xcd_barrier_complete(bar, b.x, nloc, nx); b.st[0] = nloc; b.st[1] = nx; }
        const unsigned old = xb_add(&bar[XB_XSUB(b.x)], 1u);
        const unsigned gen = old / nloc;
        if (old + 1u == (gen + 1u) * nloc) {
            __builtin_amdgcn_fence(__ATOMIC_RELEASE, "agent");
            asm volatile("s_waitcnt vmcnt(0)" ::: "memory");
            const unsigned og = xb_add(&bar[XB_TOP], 1u);
            const unsigned tg = og / nx;
            if (og + 1u == (tg + 1u) * nx) xb_add(&bar[XB_TOPGEN], 1u);
            else XB_SPIN(xb_ld(&bar[XB_TOPGEN]) == tg, bar);
            __builtin_amdgcn_fence(__ATOMIC_ACQUIRE, "agent");
            xb_add(&bar[XB_XGEN(b.x)], 1u);
            asm volatile("s_waitcnt vmcnt(0)" ::: "memory");
        } else {
            XB_SPIN(xb_ld(&bar[XB_XGEN(b.x)]) == gen, bar);
            __builtin_amdgcn_fence(__ATOMIC_ACQUIRE, "agent");
            asm volatile("s_waitcnt vmcnt(0)" ::: "memory");
        }
    }
    __syncthreads();
}

namespace pg8 {
constexpr int BM = 256, BK = 64, HALF = 128, HTB = HALF * BK * 2, STAGE_BYTES = 8 * HTB, NXCD = 8, WGM = 8;
__host__ __device__ __forceinline__ int lds_byte(int r, int c) { const int st = (r >> 4) * 2 + (c >> 5), rr = r & 15, cc = c & 31, ob = rr * 64 + cc * 2; return st * 1024 + (ob ^ (((ob >> 9) & 1) << 5)); }
__host__ __device__ __forceinline__ void stage_rc(int b, int& R, int& C) { const int st = b / 1024, sb = b % 1024, swz = sb ^ (((sb >> 9) & 1) << 5); R = (st >> 1) * 16 + swz / 64; C = (st & 1) * 32 + (swz % 64) / 2; }
__host__ __device__ __forceinline__ int perm32(int rho) { const int n = rho >> 4, i = rho & 15; return 8 * (i >> 2) + 4 * n + (i & 3); }

struct Unit { int pm, pn, e; };

struct DenseOrder {
    const char* A; const char* Bt; int K; int nM, nN, nwg, G, c;
    __device__ __forceinline__ void init(const void* A_, const void* Bt_, int M, int N, int K_, int G_, int c_) { A = (const char*)A_; Bt = (const char*)Bt_; K = K_; nM = M / BM; nN = N / BM; nwg = nM * nN; G = G_; c = c_; }
    __device__ __forceinline__ bool next(int i, Unit& u) const {
        const long L = (long)i * G + c; if (L >= nwg) return false;
        int wgid = (int)L; { const int q = nwg / NXCD, r = nwg % NXCD, xcd = wgid % NXCD, off = wgid / NXCD; wgid = (xcd < r ? xcd * (q + 1) : r * (q + 1) + (xcd - r) * q) + off; }
        const int nig = WGM * nN, gid = wgid / nig, fm = gid * WGM, gsz = (nM - fm) < WGM ? (nM - fm) : WGM;
        u.pm = fm + ((wgid % nig) % gsz); u.pn = (wgid % nig) / gsz; u.e = 0; return true;
    }
    __device__ __forceinline__ const char* a_ptr(const Unit& u) const { return A + (size_t)u.pm * ((size_t)BM * K * 2); }
    __device__ __forceinline__ const char* b_ptr(const Unit& u) const { return Bt + (size_t)u.pn * ((size_t)BM * K * 2); }
    __device__ __forceinline__ const int* rows(const Unit&) const { return nullptr; }
};
struct GroupedOrder {
    const char* A; const char* Bt; size_t estride; int K; const int* rowidx; const LAS int* ulist;
    static constexpr int GO_MAXU = 48, LIST_OFF = 131072;
    __device__ __forceinline__ void build(LAS unsigned char* lds, const int* tstart, int nN, int G, int c) {
        LAS int* L = (LAS int*)(lds + LIST_OFF); ulist = L;
        if (threadIdx.x < GO_MAXU) {
            const int i = threadIdx.x; int Gx, x, j, nlab;
            if (G % 8 == 0) { Gx = G >> 3; x = c & 7; j = c >> 3; nlab = 8; } else { Gx = G; x = 0; j = c; nlab = 1; }
            const int q = j + Gx * i; int tq = q / nN; const int pn = q - tq * nN; int pm = 0, ee = 0, ok = 0;
            for (int e = x; e < NEXP; e += nlab) { const int s0 = tstart[e], cnt = tstart[e + 1] - s0; if (tq < cnt) { pm = s0 + tq; ee = e; ok = 1; break; } tq -= cnt; }
            L[4 * i] = pm; L[4 * i + 1] = pn; L[4 * i + 2] = ee; L[4 * i + 3] = ok;
        }
        __syncthreads();
    }
    __device__ __forceinline__ bool next(int i, Unit& u) const {
        if (i >= GO_MAXU) return false;
        const LAS int* p = ulist + 4 * i; u.pm = p[0]; u.pn = p[1]; u.e = p[2]; return p[3] != 0;
    }
    __device__ __forceinline__ const char* a_ptr(const Unit& u) const { return rowidx ? A : A + (size_t)u.pm * ((size_t)BM * K * 2); }
    __device__ __forceinline__ const char* b_ptr(const Unit& u) const { return Bt + (size_t)u.e * estride + (size_t)u.pn * ((size_t)BM * K * 2); }
    __device__ __forceinline__ const int* rows(const Unit& u) const { return rowidx + u.pm * BM; }
};

typedef int v4i_t __attribute__((ext_vector_type(4)));
typedef int v8i_t __attribute__((ext_vector_type(8)));
template <class Epi, class Sched, bool GATHER, bool F8 = false>
__device__ __forceinline__ void gemm_phase(LAS unsigned char* lds, const int K, const Sched& S, const Epi& E) {
    const int tid = threadIdx.x, wid = __builtin_amdgcn_readfirstlane(tid >> 6), lane = tid & 63, wr = wid >> 2, wc = wid & 3, fr = lane & 15, fq = lane >> 4;
    const int nt = K / BK;
    unsigned voffA[2], voffB[2], rA[2], cA2[2];
#pragma unroll
    for (int i = 0; i < 2; ++i) { int R, C; stage_rc(tid * 16 + i * 8192, R, C); const int Rb = Epi::PERM ? ((R & ~31) + perm32(R & 31)) : R;
        voffA[i] = (unsigned)(R * K + C) * 2u; voffB[i] = (unsigned)(Rb * K + C) * 2u; rA[i] = (unsigned)R; cA2[i] = (unsigned)C * 2u; }
    const size_t kstep = (size_t)(BK * 2);
    const size_t hstep = (size_t)HALF * K * 2;
    const unsigned ldsw = (unsigned)wid * 1024u;
    const int aoff = lds_byte(wr * 64 + fr, fq * 8), boff = lds_byte(wc * 32 + fr, fq * 8);
#define PG8_SA(b, h) (((b) * 2 + (h)) * HTB)
#define PG8_SB(b, h) ((4 + (b) * 2 + (h)) * HTB)
#define PG8_STAGE(bufoff, gbase, voff) do { _Pragma("unroll") for (int _i = 0; _i < 2; ++_i) \
        __builtin_amdgcn_global_load_lds((const unsigned*)((const char*)(gbase) + (voff)[_i]), (LAS unsigned*)(lds + (bufoff) + ldsw + _i * 8192), 16, 0, 0); } while (0)
#define PG8_STAGE_A(bufoff, base, h, GV) do { if constexpr (GATHER) { PG8_STAGE(bufoff, base, (GV)[h]); } else { PG8_STAGE(bufoff, (base) + (h) * hstep, voffA); } } while (0)
#define PG8_LD8(p) __builtin_shufflevector(*(const LAS v4i_t*)(p), *(const LAS v4i_t*)((p) + 1024), 0, 1, 2, 3, 4, 5, 6, 7)
#define PG8_LDA(dst, b, h) do { _Pragma("unroll") for (int m = 0; m < 4; ++m) { if constexpr (F8) dst##8[m] = PG8_LD8(lds + PG8_SA(b, h) + aoff + m * 2048); else { \
        _Pragma("unroll") for (int k = 0; k < 2; ++k) dst[m][k] = *(const LAS bf16x8*)(lds + PG8_SA(b, h) + aoff + m * 2048 + k * 1024); } } } while (0)
#define PG8_LDB(dst, b, h) do { _Pragma("unroll") for (int n = 0; n < 2; ++n) { if constexpr (F8) dst##8[n] = PG8_LD8(lds + PG8_SB(b, h) + boff + n * 2048); else { \
        _Pragma("unroll") for (int k = 0; k < 2; ++k) dst[n][k] = *(const LAS bf16x8*)(lds + PG8_SB(b, h) + boff + n * 2048 + k * 1024); } } } while (0)
#define PG8_MMA(ai, bj, At, Bt) do { __builtin_amdgcn_s_setprio(1); _Pragma("unroll") for (int m = 0; m < 4; ++m) _Pragma("unroll") for (int n = 0; n < 2; ++n) { \
        if constexpr (F8) { \
            asm volatile("v_mfma_scale_f32_16x16x128_f8f6f4 %0, %1, %2, %0, %3, %3 op_sel_hi:[0,0,0]" : "+v"(acc[ai][bj][m][n]) : "v"(Bt##8[n]), "v"(At##8[m]), "v"(f8one)); } \
        else { _Pragma("unroll") for (int k = 0; k < 2; ++k) acc[ai][bj][m][n] = __builtin_amdgcn_mfma_f32_16x16x32_bf16(Bt[n][k], At[m][k], acc[ai][bj][m][n], 0, 0, 0); } } \
        __builtin_amdgcn_s_setprio(0); } while (0)
#define PG8_WAIT_V(n) asm volatile("s_waitcnt vmcnt(" #n ")" ::: "memory")
#define PG8_WAIT_L(n) asm volatile("s_waitcnt lgkmcnt(" #n ")" ::: "memory")
#define PG8_BAR __builtin_amdgcn_s_barrier()
#define PG8_SCHED __builtin_amdgcn_sched_barrier(0)
#define PG8_ROWS(GV, u) do { const int* _rp = S.rows(u); _Pragma("unroll") for (int _h = 0; _h < 2; ++_h) _Pragma("unroll") for (int _i = 0; _i < 2; ++_i) \
        (GV)[_h][_i] = (unsigned)_rp[128 * _h + rA[_i]] * (unsigned)(K * 2) + cA2[_i]; } while (0)
    Unit cur, nxt; int ui = 0;
    if (!S.next(0, cur)) return;
    f32x4 acc[2][2][4][2];
#pragma unroll
    for (int a = 0; a < 2; ++a)
#pragma unroll
        for (int b = 0; b < 2; ++b)
#pragma unroll
            for (int m = 0; m < 4; ++m)
#pragma unroll
                for (int n = 0; n < 2; ++n) acc[a][b][m][n] = (f32x4){0.f, 0.f, 0.f, 0.f};
    const int f8one = 0x7f7f7f7f;
    bf16x8 At[4][2], B0[2][2], B1[2][2]; v8i_t At8[4], B08[2], B18[2];
    unsigned cv[2][2] = {{0u, 0u}, {0u, 0u}}, nv[2][2] = {{0u, 0u}, {0u, 0u}};
    const char* cA = S.a_ptr(cur); const char* cB = S.b_ptr(cur);
    if constexpr (GATHER) PG8_ROWS(cv, cur);
    PG8_STAGE(PG8_SB(0, 0), cB, voffB); PG8_STAGE(PG8_SB(0, 1), cB + hstep, voffB); PG8_STAGE_A(PG8_SA(0, 0), cA, 0, cv); PG8_STAGE_A(PG8_SA(0, 1), cA, 1, cv);
    if (wr == 1) PG8_BAR;
    PG8_WAIT_V(2); PG8_BAR;
    PG8_STAGE(PG8_SB(1, 0), cB + kstep, voffB); PG8_STAGE_A(PG8_SA(1, 0), cA + kstep, 0, cv); PG8_STAGE(PG8_SB(1, 1), cB + hstep + kstep, voffB);
    PG8_WAIT_V(6); PG8_BAR;
    for (;;) {
        const bool has_next = S.next(ui + 1, nxt);
        const char* nA = has_next ? S.a_ptr(nxt) : cA; const char* nB = has_next ? S.b_ptr(nxt) : cB;
        if constexpr (GATHER) { if (has_next) PG8_ROWS(nv, nxt); else {
#pragma unroll
            for (int h = 0; h < 2; ++h)
#pragma unroll
                for (int i = 0; i < 2; ++i) nv[h][i] = cv[h][i]; } }
        for (int t = 0; t < nt; t += 2) {
            const bool last = (t == nt - 2);
            if constexpr (Epi::MIDK) { if (t == nt / 2) { if constexpr (F8) asm volatile("s_nop 15\n\ts_nop 15" ::: "memory"); E.midk(acc, ui, wr, fr, lds); } }
            const char* a1 = cA + (size_t)(t + 1) * kstep;
            const char* a2 = last ? nA : cA + (size_t)(t + 2) * kstep; const char* b2 = last ? nB : cB + (size_t)(t + 2) * kstep;
            const char* a3 = a2 + kstep; const char* b3 = b2 + kstep;
            unsigned av[2][2];
#pragma unroll
            for (int h = 0; h < 2; ++h)
#pragma unroll
                for (int i = 0; i < 2; ++i) av[h][i] = last ? nv[h][i] : cv[h][i];
            PG8_LDB(B0, 0, 0); PG8_LDB(B1, 0, 1); PG8_SCHED; PG8_LDA(At, 0, 0); PG8_STAGE_A(PG8_SA(1, 1), a1, 1, cv);
            PG8_WAIT_V(8); PG8_WAIT_L(0); PG8_BAR; PG8_MMA(0, 0, At, B0); PG8_MMA(0, 1, At, B1); PG8_BAR; PG8_SCHED;
            PG8_LDA(At, 0, 1); PG8_STAGE(PG8_SB(0, 0), b2, voffB); PG8_STAGE(PG8_SB(0, 1), b2 + hstep, voffB); PG8_STAGE_A(PG8_SA(0, 0), a2, 0, av);
            PG8_WAIT_V(8); PG8_WAIT_L(0); PG8_BAR; PG8_MMA(1, 0, At, B0); PG8_MMA(1, 1, At, B1); PG8_BAR; PG8_SCHED;
            PG8_LDB(B0, 1, 0); PG8_LDB(B1, 1, 1); PG8_SCHED; PG8_LDA(At, 1, 0); PG8_STAGE_A(PG8_SA(0, 1), a2, 1, av);
            PG8_WAIT_V(8); PG8_WAIT_L(0); PG8_BAR; PG8_MMA(0, 0, At, B0); PG8_MMA(0, 1, At, B1); PG8_BAR; PG8_SCHED;
            PG8_LDA(At, 1, 1); PG8_STAGE(PG8_SB(1, 0), b3, voffB); PG8_STAGE(PG8_SB(1, 1), b3 + hstep, voffB); PG8_STAGE_A(PG8_SA(1, 0), a3, 0, av);
            PG8_WAIT_V(8); PG8_WAIT_L(0); PG8_BAR; PG8_MMA(1, 0, At, B0); PG8_MMA(1, 1, At, B1); PG8_BAR; PG8_SCHED;
        }
        if constexpr (F8) asm volatile("s_nop 15\n\ts_nop 15\n\ts_nop 7" ::: "memory");
        if (wr == 0) PG8_BAR;
        for (int er = 0; er < (Epi::PROBE_REP ? EPI_REPS : 1); ++er) { if constexpr (Epi::MIDK) E.fin(acc, cur, ui, wr, wc, fr, fq, lds); else E(acc, cur, wr, wc, fr, fq); }
        if (!has_next) break;
#pragma unroll
        for (int a = 0; a < 2; ++a)
#pragma unroll
            for (int b = 0; b < 2; ++b)
#pragma unroll
                for (int m = 0; m < 4; ++m)
#pragma unroll
                    for (int n = 0; n < 2; ++n) acc[a][b][m][n] = (f32x4){0.f, 0.f, 0.f, 0.f};
        cur = nxt; cA = nA; cB = nB; ++ui;
#pragma unroll
        for (int h = 0; h < 2; ++h)
#pragma unroll
            for (int i = 0; i < 2; ++i) cv[h][i] = nv[h][i];
        if (wr == 1) PG8_BAR;
    }
    PG8_WAIT_V(0);
    PG8_BAR;
#undef PG8_SA
#undef PG8_SB
#undef PG8_STAGE
#undef PG8_STAGE_A
#undef PG8_LDA
#undef PG8_LDB
#undef PG8_MMA
#undef PG8_LD8
#undef PG8_WAIT_V
#undef PG8_WAIT_L
#undef PG8_BAR
#undef PG8_SCHED
#undef PG8_ROWS
}

struct EpiQKV {
    static constexpr bool PERM = true, PROBE_REP = false, MIDK = false;
    bf16* O; bf16* KVH;
    __device__ __forceinline__ void operator()(const f32x4 (&acc)[2][2][4][2], const Unit& u, int wr, int wc, int fr, int fq) const {
        const int row0 = u.pm * BM + wr * 64 + fr;
        const bool isq = (u.pn < 4 || (u.pn >= 6 && u.pn < 10));
        const size_t tb = (u.pn == 4) ? KVH_KA : (u.pn == 5) ? KVH_VA : (u.pn < 14) ? KVH_KB + (size_t)(u.pn - 10) * 4 * NT * 64 * 2 : KVH_VB + (size_t)(u.pn - 14) * 4 * NT * 64 * 2;
        bf16* P = isq ? O : (bf16*)((unsigned char*)KVH + tb);
        const int pitch = isq ? DIN : 64; const float sc = isq ? 0.125f * LOG2E : 1.0f;
        const int cin = wc * 32 + 8 * fq;
        size_t coff[2];
#pragma unroll
        for (int bj = 0; bj < 2; ++bj) { const int c = bj * HALF + cin; coff[bj] = isq ? (size_t)(u.pn * BM + c) : ((size_t)(c >> 6) * NT * 64 + (c & 63)); }
#pragma unroll
        for (int ai = 0; ai < 2; ++ai)
#pragma unroll
            for (int m = 0; m < 4; ++m) { bf16* rowp = P + (size_t)(row0 + ai * HALF + m * 16) * pitch;
#pragma unroll
                for (int bj = 0; bj < 2; ++bj) { const f32x4 v0 = acc[ai][bj][m][0] * sc, v1 = acc[ai][bj][m][1] * sc;
                    u32x4 w; w.x = cvtpk(v0[0], v0[1]); w.y = cvtpk(v0[2], v0[3]); w.z = cvtpk(v1[0], v1[1]); w.w = cvtpk(v1[2], v1[3]);
                    *(u32x4*)(rowp + coff[bj]) = w; } }
    }
};
struct EpiRes {
    static constexpr bool PERM = true, PROBE_REP = true, MIDK = true;
    const float* X; bf16* X1; const float* mod; const float* SSQ; float* RSS;
    static constexpr int TAB_OFF = 131072;
    __device__ __forceinline__ void midk(f32x4 (&acc)[2][2][4][2], int ui, int wr, int fr, LAS unsigned char* lds) const {
        const LAS float* tab = (const LAS float*)(lds + TAB_OFF) + (size_t)ui * 512;
#pragma unroll
        for (int ai = 0; ai < 2; ++ai)
#pragma unroll
            for (int m = 0; m < 4; ++m) { const float ratio = tab[2 * (ai * HALF + wr * 64 + m * 16 + fr)];
#pragma unroll
                for (int bj = 0; bj < 2; ++bj)
#pragma unroll
                    for (int n = 0; n < 2; ++n) acc[ai][bj][m][n] = acc[ai][bj][m][n] * ratio; }
    }
    __device__ __forceinline__ void fin(const f32x4 (&acc)[2][2][4][2], const Unit& u, int ui, int wr, int wc, int fr, int fq, LAS unsigned char* lds) const {
        const LAS float* tab = (const LAS float*)(lds + TAB_OFF) + (size_t)ui * 512;
        const int row0 = u.pm * BM + wr * 64 + fr, col0 = u.pn * BM + wc * 32 + 8 * fq;
        const float* gt = mod + (size_t)(u.pm >> 4) * 16384 + 4096;
        f32x4 gv[2][2];
#pragma unroll
        for (int bj = 0; bj < 2; ++bj)
#pragma unroll
            for (int n = 0; n < 2; ++n) gv[bj][n] = *(const f32x4*)(gt + col0 + bj * HALF + 4 * n);
#pragma unroll
        for (int ai = 0; ai < 2; ++ai)
#pragma unroll
            for (int m = 0; m < 4; ++m) { const int rl = ai * HALF + wr * 64 + m * 16 + fr; const size_t off = (size_t)(u.pm * BM + rl) * DM + col0;
                const float rB = tab[2 * rl + 1];
#pragma unroll
                for (int bj = 0; bj < 2; ++bj) { const f32x4 x0 = __builtin_nontemporal_load((const f32x4*)(X + off + bj * HALF)), x1 = __builtin_nontemporal_load((const f32x4*)(X + off + bj * HALF + 4));
                    const f32x4 v0 = x0 + gv[bj][0] * (acc[ai][bj][m][0] * rB), v1 = x1 + gv[bj][1] * (acc[ai][bj][m][1] * rB);
                    u32x4 w; w.x = cvtpk(v0[0], v0[1]); w.y = cvtpk(v0[2], v0[3]); w.z = cvtpk(v1[0], v1[1]); w.w = cvtpk(v1[2], v1[3]);
                    *(u32x4*)(X1 + off + bj * HALF) = w;
                    float p = (v0[0] * v0[0] + v0[1] * v0[1]) + (v0[2] * v0[2] + v0[3] * v0[3]) + (v1[0] * v1[0] + v1[1] * v1[1]) + (v1[2] * v1[2] + v1[3] * v1[3]);
                    p += __shfl_xor(p, 16); p += __shfl_xor(p, 32);
                    if (fq == 0) RSS[(size_t)(u.pm * BM + rl) * 64 + u.pn * 8 + wc * 2 + bj] = p; }
                asm volatile("" ::: "memory"); }
        (void)row0;
    }
    __device__ __forceinline__ void operator()(const f32x4 (&)[2][2][4][2], const Unit&, int, int, int, int) const {}
};
struct EpiGU {
    static constexpr bool PERM = true, PROBE_REP = false, MIDK = false;
    unsigned char* ACT;
    __device__ __forceinline__ void operator()(const f32x4 (&acc)[2][2][4][2], const Unit& u, int wr, int wc, int fr, int fq) const {
        const int row0 = u.pm * BM + wr * 64 + fr, col0 = u.pn * 128 + wc * 32 + 8 * fq; constexpr float us = 1.0f / (F8_SH * F8_SWGU);
#pragma unroll
        for (int ai = 0; ai < 2; ++ai)
#pragma unroll
            for (int m = 0; m < 4; ++m) { float r[8];
#pragma unroll
                for (int n = 0; n < 2; ++n)
#pragma unroll
                    for (int j = 0; j < 4; ++j) { const float g = acc[ai][0][m][n][j] * us, up = acc[ai][1][m][n][j] * us;
                        r[4 * n + j] = g * __builtin_amdgcn_rcpf(1.0f + __expf(-g)) * up * F8_SACT; }
                u32x2 w; w.x = cvt4_fp8(r[0], r[1], r[2], r[3]); w.y = cvt4_fp8(r[4], r[5], r[6], r[7]);
                *(u32x2*)(ACT + (size_t)(row0 + ai * HALF + m * 16) * DE + col0) = w; }
    }
};
struct EpiY {
    static constexpr bool PERM = true, PROBE_REP = false, MIDK = false;
    unsigned char* Y;
    __device__ __forceinline__ void operator()(const f32x4 (&acc)[2][2][4][2], const Unit& u, int wr, int wc, int fr, int fq) const {
        const int row0 = u.pm * BM + wr * 64 + fr, col0 = u.pn * BM + wc * 32 + 8 * fq;
#pragma unroll
        for (int ai = 0; ai < 2; ++ai)
#pragma unroll
            for (int m = 0; m < 4; ++m) { unsigned char* rowp = Y + (size_t)(row0 + ai * HALF + m * 16) * DM + col0;
#pragma unroll
                for (int bj = 0; bj < 2; ++bj) { constexpr float us = F8_SY / (F8_SACT * F8_SWD); const f32x4 v0 = acc[ai][bj][m][0] * us, v1 = acc[ai][bj][m][1] * us;
                    u32x2 w; w.x = cvt4_fp8(v0[0], v0[1], v0[2], v0[3]); w.y = cvt4_fp8(v1[0], v1[1], v1[2], v1[3]);
                    *(u32x2*)(rowp + bj * HALF) = w; } }
    }
};
}

struct Args { const float* in[22]; float* out; unsigned char* ws; int ph_lo, ph_hi; };
struct InPtrs {
    __device__ __forceinline__ const float* operator[](int k) const {
        const __attribute__((address_space(4))) char* p = (const __attribute__((address_space(4))) char*)__builtin_amdgcn_kernarg_segment_ptr();
        asm volatile("" : "+s"(p));
        return *(const float* const __attribute__((address_space(4)))*)(p + 8 * k);
    }
};
struct Ctx { InPtrs in; float* out; unsigned char* ws; };
static_assert(__builtin_offsetof(Args, in) == 0, "InPtrs reads Args::in at kernarg offset 0");
enum { I_X = 0, I_C, I_WADA, I_BADA, I_GMIX, I_WIN, I_SINKS, I_RELB, I_GOA, I_GOB, I_WOUT, I_GFFN, I_WRG, I_BRG, I_WRE, I_BRE, I_WGATE, I_WUP, I_WDOWN, I_WADAF, I_BADAF, I_GFIN };

__device__ __forceinline__ void p0_mod(const Ctx& a, LAS unsigned char* lds, int tid, int lane, int wave) {
    LAS float* cact = (LAS float*)lds;
    LAS float* red = (LAS float*)(lds + 32768);
    const float* c = a.in[I_C];
    for (int i = tid; i < 2048 * 4; i += 512) { const int b = i >> 11, k = i & 2047; const float v = c[i]; cact[k * 4 + b] = v / (1.0f + __expf(-v)); }
    __syncthreads();
    float* mod = (float*)(a.ws + WS_MOD);
    const int rsub = lane >> 4, cq = lane & 15;
    for (int cg = blockIdx.x; cg < 256; cg += gridDim.x) {
        const int col0 = cg * 64;
        const float* W; int ldw; const float* bias; int cc;
        if (col0 < 12288) { W = a.in[I_WADA]; ldw = 12288; bias = a.in[I_BADA]; cc = col0; } else { W = a.in[I_WADAF]; ldw = 4096; bias = a.in[I_BADAF]; cc = col0 - 12288; }
        float acc[4][4];
#pragma unroll
        for (int b = 0; b < 4; ++b)
#pragma unroll
            for (int j = 0; j < 4; ++j) acc[b][j] = 0.f;
        const float* wp = W + (size_t)(wave * 256 + rsub) * ldw + cc + 4 * cq;
#pragma unroll 8
        for (int i = 0; i < 64; ++i) {
            const f32x4 wv = __builtin_nontemporal_load((const f32x4*)(wp + (size_t)(4 * i) * ldw));
            const f32x4 ca = *(const LAS f32x4*)(cact + (wave * 256 + 4 * i + rsub) * 4);
#pragma unroll
            for (int b = 0; b < 4; ++b)
#pragma unroll
                for (int j = 0; j < 4; ++j) acc[b][j] += ca[b] * wv[j];
        }
#pragma unroll
        for (int b = 0; b < 4; ++b)
#pragma unroll
            for (int j = 0; j < 4; ++j) { float v = acc[b][j]; v += __shfl_xor(v, 16); v += __shfl_xor(v, 32); if (lane < 16) red[(wave * 4 + b) * 64 + 4 * cq + j] = v; }
        __syncthreads();
        if (tid < 256) { const int b = tid >> 6, col = tid & 63; float s = bias[cc + col];
#pragma unroll
            for (int w = 0; w < 8; ++w) s += red[(w * 4 + b) * 64 + col];
            mod[(size_t)b * 16384 + col0 + col] = s; }
        __syncthreads();
    }
}
template <bool NTS>
__device__ __forceinline__ void transpose_item(const float* W, int ldw, int k0, int n0, const float* kscale, bf16* dst, int Kd, LAS float* scr, int lane) {
    const int r = lane >> 4, q = lane & 15;
#pragma unroll 4
    for (int i = 0; i < 16; ++i) { const int kk = 4 * i + r; f32x4 v = __builtin_nontemporal_load((const f32x4*)(W + (size_t)(k0 + kk) * ldw + n0 + 4 * q));
        if (kscale) { const float s = kscale[k0 + kk]; v = v * s; }
        LAS float* sp = scr + kk * 65 + 4 * q; sp[0] = v[0]; sp[1] = v[1]; sp[2] = v[2]; sp[3] = v[3]; }
    LDS_WAIT();
    const int c = lane & 7;
#pragma unroll
    for (int j = 0; j < 8; ++j) { const int n = (lane >> 3) + 8 * j; const LAS float* s = scr + (8 * c) * 65 + n;
        u32x4 o; o.x = cvtpk(s[0 * 65], s[1 * 65]); o.y = cvtpk(s[2 * 65], s[3 * 65]); o.z = cvtpk(s[4 * 65], s[5 * 65]); o.w = cvtpk(s[6 * 65], s[7 * 65]);
        if (NTS) __builtin_nontemporal_store(o, (u32x4*)(dst + (size_t)n * Kd + 8 * c)); else *(u32x4*)(dst + (size_t)n * Kd + 8 * c) = o; }
    LDS_WAIT();
}
template <bool NTS>
__device__ __forceinline__ void transpose_item8(const float* W, int ldw, int k0, int n0, float scale, const float* kscale, unsigned char* dst8, int Kd, LAS float* scr, int lane) {
    const int r = lane >> 3, q = lane & 7;
    f32x4 v[16];
#pragma unroll
    for (int i = 0; i < 16; ++i) v[i] = __builtin_nontemporal_load((const f32x4*)(W + (size_t)(k0 + 8 * i + r) * ldw + n0 + 4 * q));
#pragma unroll
    for (int i = 0; i < 16; ++i) { if (kscale) v[i] = v[i] * kscale[k0 + 8 * i + r]; LAS float* sp = scr + (8 * i + r) * 33 + 4 * q; sp[0] = v[i][0]; sp[1] = v[i][1]; sp[2] = v[i][2]; sp[3] = v[i][3]; }
    LDS_WAIT();
    const int c = lane >> 3, nl = lane & 7;
#pragma unroll
    for (int j = 0; j < 4; ++j) { const int n = nl + 8 * j; const LAS float* sq = scr + (16 * c) * 33 + n; u32x4 o;
        o.x = cvt4_fp8(sq[0 * 33] * scale, sq[1 * 33] * scale, sq[2 * 33] * scale, sq[3 * 33] * scale); o.y = cvt4_fp8(sq[4 * 33] * scale, sq[5 * 33] * scale, sq[6 * 33] * scale, sq[7 * 33] * scale);
        o.z = cvt4_fp8(sq[8 * 33] * scale, sq[9 * 33] * scale, sq[10 * 33] * scale, sq[11 * 33] * scale); o.w = cvt4_fp8(sq[12 * 33] * scale, sq[13 * 33] * scale, sq[14 * 33] * scale, sq[15 * 33] * scale);
        if (NTS) __builtin_nontemporal_store(o, (u32x4*)(dst8 + (size_t)n * Kd + 16 * c)); else *(u32x4*)(dst8 + (size_t)n * Kd + 16 * c) = o; }
    LDS_WAIT();
}
constexpr int CV_IN = 32 * 72, CV_OUT = 32 * 32, CV_G = 32 * 256, CV_D = 32 * 256;
constexpr int CV_UP0 = CV_IN + CV_OUT + CV_G, CV_DN0 = CV_UP0 + CV_G, CV_ALL = CV_DN0 + CV_D;
constexpr int CV_G_P4 = CV_IN + CV_OUT + 20 * 256;
constexpr int CV_UP_TAIL = CV_UP0 + 10 * 256, CV_DN_TAIL = CV_DN0 + 0 * 256;
__device__ __forceinline__ void convert_items(const Ctx& a, LAS unsigned char* lds, int lane, int wave, int first, int last, int gw, int NGW) {
    LAS float* scr = (LAS float*)(lds + wave * 16896);
    bf16* WinT = (bf16*)(a.ws + WS_WIN); unsigned char* WoutT = a.ws + WS_WOUT; unsigned char* WguT = a.ws + WS_WGU; unsigned char* WdT = a.ws + WS_WD;
    for (int it = first + gw; it < last; it += NGW) {
        int r = it;
        if (r < CV_IN) { const int kb = r / 72, nb = r % 72; transpose_item<false>(a.in[I_WIN], DIN, 64 * kb, 64 * nb, nullptr, WinT + (size_t)(64 * nb) * DM + 64 * kb, DM, scr, lane); continue; } r -= CV_IN;
        if (r < CV_OUT) { const int kb = r >> 6, nb = r & 63; const float* ks = (kb < 8) ? a.in[I_GOA] : (a.in[I_GOB] - 1024);
            transpose_item8<true>(a.in[I_WOUT], DM, 128 * kb, 32 * nb, F8_SWO, ks, WoutT + (size_t)(32 * nb) * DM + 128 * kb, DM, scr, lane); continue; } r -= CV_OUT;
        if (r < 2 * CV_G) { const int up = r >= CV_G ? 1 : 0; if (up) r -= CV_G; const int e = r >> 8, rr = r & 255, kb = rr >> 4, nb = rr & 15, n0 = 32 * nb;
            const int drow = 256 * (n0 >> 7) + (n0 & 127) + 128 * up;
            transpose_item8<true>(a.in[up ? I_WUP : I_WGATE] + (size_t)e * DM * DE, DE, 128 * kb, n0, F8_SWGU, nullptr, WguT + ((size_t)e * 1024 + drow) * DM + 128 * kb, DM, scr, lane); continue; } r -= 2 * CV_G;
        { const int e = r >> 8, rr = r & 255, kb = rr >> 6, nb = rr & 63;
            transpose_item8<true>(a.in[I_WDOWN] + (size_t)e * DE * DM, DM, 128 * kb, 32 * nb, F8_SWD, nullptr, WdT + ((size_t)e * DM + 32 * nb) * DE + 128 * kb, DE, scr, lane); }
    }
}
__device__ __forceinline__ void p0_convert(const Ctx& a, LAS unsigned char* lds, int tid, int lane, int wave) {
    convert_items(a, lds, lane, wave, 0, CV_G_P4, blockIdx.x * 8 + wave, gridDim.x * 8);
    convert_items(a, lds, lane, wave, CV_UP0, CV_UP_TAIL, blockIdx.x * 8 + wave, gridDim.x * 8);
    convert_items(a, lds, lane, wave, CV_DN0, CV_DN_TAIL, blockIdx.x * 8 + wave, gridDim.x * 8);
    bf16* wrhi = (bf16*)(a.ws + WS_WRT); bf16* wrlo = wrhi + 48 * 2048;
    for (int i = blockIdx.x * 512 + tid; i < 48 * 2048; i += gridDim.x * 512) { const int col = i >> 11, k = i & 2047;
        const float v = col < 4 ? a.in[I_WRG][k * 4 + col] : (col < 36 ? a.in[I_WRE][k * 32 + col - 4] : 0.f);
        const unsigned h = cvtpk(v, 0.f); const float hf = bf_lo(h); const unsigned l = cvtpk(v - hf, 0.f);
        wrhi[i] = (bf16)(h & 0xffffu); wrlo[i] = (bf16)(l & 0xffffu); }
}

__device__ __forceinline__ void p1_norm(const Ctx& a, int lane, int wave) {
    const float* x = a.in[I_X]; const float* g = a.in[I_GMIX]; const float* mod = (const float*)(a.ws + WS_MOD); bf16* H = (bf16*)(a.ws + WS_H);
    const int gw = blockIdx.x * 8 + wave, NGW = gridDim.x * 8;
    { float* aux = (float*)(a.ws + WS_AUX);
      for (int i = gw; i < 4 * 36; i += NGW) { const int b = i / 36, c = i % 36; const float* sh = mod + (size_t)b * 16384 + 6144; float sacc = 0.f;
          for (int k = lane; k < DM; k += 64) sacc += sh[k] * (c < 4 ? a.in[I_WRG][k * 4 + c] : a.in[I_WRE][k * 32 + c - 4]);
          sacc = wave_sum(sacc); if (lane == 0) aux[b * 48 + c] = sacc + (c < 4 ? a.in[I_BRG][c] : a.in[I_BRE][c - 4]); }
      for (int i = blockIdx.x * 512 + threadIdx.x; i < 4 * DM; i += gridDim.x * 512) { const int b = i >> 11, k = i & 2047; aux[1024 + i] = a.in[I_GFFN][k] * (1.0f + mod[(size_t)b * 16384 + 8192 + k]); } }
    for (int grp = gw; grp < NT / 8; grp += NGW) {
        const int row0 = grp * 8, b = row0 >> 12;
        f32x4 A[8], Bv[8];
#pragma unroll
        for (int j = 0; j < 8; ++j) { const int k = 4 * lane + 256 * j; const f32x4 gg = *(const f32x4*)(g + k), sc = *(const f32x4*)(mod + (size_t)b * 16384 + 2048 + k);
            A[j] = gg * (1.0f + sc); Bv[j] = *(const f32x4*)(mod + (size_t)b * 16384 + k); }
        for (int r = 0; r < 8; ++r) {
            const float* xr = x + (size_t)(row0 + r) * DM + 4 * lane; f32x4 v[8]; float s = 0.f;
#pragma unroll
            for (int j = 0; j < 8; ++j) { v[j] = __builtin_nontemporal_load((const f32x4*)(xr + 256 * j)); s += (v[j][0] * v[j][0] + v[j][1] * v[j][1]) + (v[j][2] * v[j][2] + v[j][3] * v[j][3]); }
            const float rstd = __builtin_amdgcn_rsqf(wave_sum(s) * (1.0f / DM) + EPS);
            bf16* hr = H + (size_t)(row0 + r) * DM + 4 * lane;
#pragma unroll
            for (int j = 0; j < 8; ++j) { const f32x4 h = v[j] * rstd * A[j] + Bv[j]; u32x2 w; w.x = cvtpk(h[0], h[1]); w.y = cvtpk(h[2], h[3]); *(u32x2*)(hr + 256 * j) = w; }
        }
    }
}

__device__ __forceinline__ void att_glds16(unsigned voff, const void* sbase, unsigned lds_dst) { unsigned keep;
    asm volatile("s_mov_b32 %0, m0\n\ts_mov_b32 m0, %3\n\ts_nop 0\n\tglobal_load_lds_dwordx4 %1, %2\n\ts_mov_b32 m0, %0" : "=&s"(keep) : "v"(voff), "s"(sbase), "s"(lds_dst) : "memory"); }
__device__ __forceinline__ void att_dma_tile(const bf16* base, unsigned lds0, unsigned vo0, unsigned vo1) {
    unsigned keep;
#pragma unroll
    for (int h = 0; h < 2; ++h) {
        asm volatile("s_mov_b32 %0, m0\n\ts_mov_b32 m0, %4\n\ts_nop 0\n\t"
                     "global_load_lds_dwordx4 %1, %3\n\tglobal_load_lds_dwordx4 %2, %3 offset:1024\n\tglobal_load_lds_dwordx4 %1, %3 offset:2048\n\tglobal_load_lds_dwordx4 %2, %3 offset:3072\n\t"
                     "s_mov_b32 m0, %0" : "=&s"(keep) : "v"(vo0), "v"(vo1), "s"(base), "s"(lds0) : "memory");
        base += 4 * 8 * 64; lds0 += 4096u; asm volatile("" : "+s"(base), "+s"(lds0));
    }
}
#define ATT_DMAK(KB) att_dma_tile((KB), klu, kvo0, kvo0 ^ 64u)
#define ATT_DMAV(VB) att_dma_tile((VB), klu + 8192u, vvo, vvo)
__device__ __forceinline__ void att_scores(f32x16& s0, f32x16& s1, const bf16x8 (&qf)[4], const LAS unsigned char* kfp, int hh, int km, const LAS float* tbl,
                                           bool isA, int dd, float nslope2, float cb, int base0, float moff) {
    int bl = base0; asm volatile("" : "+v"(bl));
    const float fbl = (float)bl; float cadd = 0.f;
    if (isA) {
        if (dd > 0) { const float c00 = nslope2 * (fbl + 64.0f * (float)dd) - moff, c01 = c00 - 32.0f * nslope2;
#pragma unroll
            for (int r = 0; r < 16; ++r) { const float noff = -(float)((r & 3) + 8 * (r >> 2)); s0[r] = fmaf(nslope2, noff, c00); s1[r] = fmaf(nslope2, noff, c01); } }
        else { const float nm = -moff;
#pragma unroll
            for (int r = 0; r < 16; ++r) { const float off = (float)((r & 3) + 8 * (r >> 2)); s0[r] = fmaf(nslope2, fabsf(fbl - off), nm); s1[r] = fmaf(nslope2, fabsf(fbl - (off + 32.0f)), nm); } }
    } else if (dd >= 3) { cadd = cb - moff;
#pragma unroll
        for (int r = 0; r < 16; ++r) { s0[r] = 0.f; s1[r] = 0.f; }
    } else {
        const LAS float* p0 = tbl + (bl + 64 * dd + 64 - 27); const LAS float* p1 = p0 - 32;
#pragma unroll
        for (int r = 0; r < 16; ++r) { s0[r] = p0[27 - ((r & 3) + 8 * (r >> 2))] - moff; s1[r] = p1[27 - ((r & 3) + 8 * (r >> 2))] - moff; } }
    bf16x8 kf[8];
#pragma unroll
    for (int kt = 0; kt < 2; ++kt)
#pragma unroll
        for (int ks = 0; ks < 4; ++ks) kf[4 * kt + ks] = *(const LAS bf16x8*)(kfp + kt * 4096 + (((2 * ks + hh) ^ km) << 4));
#pragma unroll
    for (int ks = 0; ks < 4; ++ks) { s0 = __builtin_amdgcn_mfma_f32_32x32x16_bf16(kf[ks], qf[ks], s0, 0, 0, 0); s1 = __builtin_amdgcn_mfma_f32_32x32x16_bf16(kf[4 + ks], qf[ks], s1, 0, 0, 0); }
    if (!isA && dd >= 3) {
#pragma unroll
        for (int r = 0; r < 16; ++r) { s0[r] += cadd; s1[r] += cadd; } }
}
constexpr float ATT_THR = 4.0f;
template <bool FIRSTHALF>
__device__ __forceinline__ void att_softmax_pv(f32x16& s0, f32x16& s1, f32x16& o0, f32x16& o1, float& m2, float& l, const LAS unsigned char* vl, int tr0, bool first) {
    float mx = fmaxf(s0[0], s1[0]);
#pragma unroll
    for (int r = 1; r < 16; ++r) mx = fmaxf(fmaxf(mx, s0[r]), s1[r]);
    { const auto rr = __builtin_amdgcn_permlane32_swap(__float_as_uint(mx), __float_as_uint(mx), false, false); mx = fmaxf(__uint_as_float(rr[0]), __uint_as_float(rr[1])); }
    if (first || __any(mx > ATT_THR)) {
        float delta;
        if (first) { delta = mx; m2 = mx; }
        else { delta = fmaxf(mx, 0.f); m2 += delta; const float alpha = __builtin_amdgcn_exp2f(-delta); l *= alpha;
#pragma unroll
            for (int r = 0; r < 16; ++r) { float a0 = o0[r], a1 = o1[r]; asm volatile("v_mul_f32 %0, %2, %0\n\tv_mul_f32 %1, %2, %1" : "+v"(a0), "+v"(a1) : "v"(alpha)); o0[r] = a0; o1[r] = a1; } }
#pragma unroll
        for (int r = 0; r < 16; ++r) { float a0 = s0[r], a1 = s1[r]; asm volatile("v_sub_f32 %0, %0, %2\n\tv_sub_f32 %1, %1, %2" : "+v"(a0), "+v"(a1) : "v"(delta)); s0[r] = a0; s1[r] = a1; }
    }
    float rs = 0.f;
#pragma unroll
    for (int r = 0; r < 16; ++r) { s0[r] = __builtin_amdgcn_exp2f(s0[r]); s1[r] = __builtin_amdgcn_exp2f(s1[r]); rs += s0[r] + s1[r]; }
    l += rs;
    bf16x8 pb[2][2];
#pragma unroll
    for (int s = 0; s < 2; ++s) {
        u32x4 w0, w1;
        w0.x = cvtpk(s0[8 * s + 0], s0[8 * s + 1]); w0.y = cvtpk(s0[8 * s + 2], s0[8 * s + 3]); w0.z = cvtpk(s0[8 * s + 4], s0[8 * s + 5]); w0.w = cvtpk(s0[8 * s + 6], s0[8 * s + 7]);
        w1.x = cvtpk(s1[8 * s + 0], s1[8 * s + 1]); w1.y = cvtpk(s1[8 * s + 2], s1[8 * s + 3]); w1.z = cvtpk(s1[8 * s + 4], s1[8 * s + 5]); w1.w = cvtpk(s1[8 * s + 6], s1[8 * s + 7]);
        pb[0][s] = __builtin_bit_cast(bf16x8, w0); pb[1][s] = __builtin_bit_cast(bf16x8, w1); }
    if (FIRSTHALF) asm volatile("s_waitcnt vmcnt(0)" ::: "memory");
#pragma unroll
    for (int kt = 0; kt < 2; ++kt)
#pragma unroll
        for (int s = 0; s < 2; ++s)
#pragma unroll
            for (int dt = 0; dt < 2; ++dt) {
                const LAS unsigned char* ap = vl + (dt ? (tr0 ^ 64) : tr0) + (32 * kt + 16 * s) * 128;
                const s16x4 r1 = __builtin_bit_cast(s16x4, __builtin_amdgcn_ds_read_tr16_b64_v4i16((LAS s16x4*)ap));
                const s16x4 r2 = __builtin_bit_cast(s16x4, __builtin_amdgcn_ds_read_tr16_b64_v4i16((LAS s16x4*)(ap + 8 * 128)));
                const bf16x8 av = {r1[0], r1[1], r1[2], r1[3], r2[0], r2[1], r2[2], r2[3]};
                if (dt == 0) o0 = __builtin_amdgcn_mfma_f32_32x32x16_bf16(av, pb[kt][s], o0, 0, 0, 0);
                else o1 = __builtin_amdgcn_mfma_f32_32x32x16_bf16(av, pb[kt][s], o1, 0, 0, 0); }
}
__device__ __forceinline__ void p3_attn(const Ctx& a, LAS unsigned char* lds, int tid, int lane, int wave) {
    const bf16* qkv = (const bf16*)(a.ws + WS_QKV); unsigned char* O = a.ws + WS_O;
    const unsigned char* kvh = a.ws + WS_KVH;
    const float* sinks = a.in[I_SINKS]; const float* relb = a.in[I_RELB];
    LAS unsigned char* kl = lds + wave * 16384;
    LAS unsigned char* vl = kl + 8192;
    LAS float* tbl = (LAS float*)(lds + 131072 + wave * 1056);
    LAS float* ssqp = (LAS float*)(lds + 131072 + 8 * 1056);
    LAS float* rstd = (LAS float*)(lds + 131072 + 8 * 1056 + 8192);
    static_assert(131072 + 8 * 1056 + 8192 + 512 <= MISC_OFF, "attention LDS map");
    const int l31 = lane & 31, hh = lane >> 5;
    const int grp = lane >> 4, i16 = lane & 15;
    const int base0 = l31 - 4 * hh;
    const int vrow = lane >> 3, vch = lane & 7;
    const unsigned kvo0 = (unsigned)(vrow * 64 + 8 * (vch ^ ((lane >> 4) & 7))) * 2u, vvo = (unsigned)(vrow * 64 + 8 * (vch ^ (4 * ((lane >> 4) & 1)))) * 2u;
    const int km = (l31 >> 1) & 7, kro = l31 * 128;
    const int trrow = (4 * hh + (i16 >> 2)) * 128, trc0 = (2 * (grp & 1) + ((i16 & 3) >> 1)) ^ (4 * ((i16 >> 3) & 1));
    const int tr0 = trrow + trc0 * 16 + (i16 & 1) * 8;
    for (int u0 = blockIdx.x; u0 < 256; u0 += gridDim.x) {
        const int unit = (gridDim.x == 256) ? ((u0 & 7) * 32 + (u0 >> 3)) : u0;
        const int b = unit >> 6, ci = unit & 63, tok0 = b * SEQ + ci * 64;
        const int dmaxA = ci < 2 ? ci : 2, dmaxB = ci < 8 ? ci : 8;
        {
            const unsigned klu = (unsigned)(__UINTPTR_TYPE__)kl;
            const int kvn = wave >> 2, ktok0 = tok0;
            const bf16* kp = (const bf16*)(kvh + KVH_KA) + ((size_t)kvn * NT + ktok0) * 64; ATT_DMAK(kp);
            const bf16* vp = (const bf16*)(kvh + KVH_VA) + ((size_t)kvn * NT + ktok0) * 64; ATT_DMAV(vp);
        }
        bf16x8 qn0[4], qn1[4];
        { const bf16* qp = qkv + (size_t)(tok0 + l31) * DIN + COL_QA + wave * 64 + 8 * hh;
#pragma unroll
          for (int ks = 0; ks < 4; ++ks) { qn0[ks] = __builtin_nontemporal_load((const bf16x8*)(qp + 16 * ks)); qn1[ks] = __builtin_nontemporal_load((const bf16x8*)(qp + (size_t)32 * DIN + 16 * ks)); } }
        for (int it = 0; it < 4; ++it) {
            const int head = wave + 8 * it;
            const bool isA = it < 2;
            bf16x8 qf0[4], qf1[4];
            asm volatile("" :: "v"(qn0[0]), "v"(qn0[1]), "v"(qn0[2]), "v"(qn0[3]), "v"(qn1[0]), "v"(qn1[1]), "v"(qn1[2]), "v"(qn1[3]));
#pragma unroll
            for (int ks = 0; ks < 4; ++ks) { qf0[ks] = qn0[ks]; qf1[ks] = qn1[ks]; }
            const bf16 *kb0, *vb0; int dmax; float m2a, la, nslope2 = 0.f, cb = 0.f;
            if (isA) { const size_t ho = ((size_t)(head >> 2) * NT + tok0) * 64; kb0 = (const bf16*)(kvh + KVH_KA) + ho; vb0 = (const bf16*)(kvh + KVH_VA) + ho; dmax = dmaxA;
                m2a = sinks[head] * LOG2E; la = hh == 0 ? 1.0f : 0.f; nslope2 = -__builtin_amdgcn_exp2f(-0.5f * (float)(head + 1)) * LOG2E; }
            else { const int hb = head - 16; const size_t ho = ((size_t)hb * NT + tok0) * 64; kb0 = (const bf16*)(kvh + KVH_KB) + ho; vb0 = (const bf16*)(kvh + KVH_VB) + ho; dmax = dmaxB; m2a = -1e30f; la = 0.f;
                for (int i = lane; i < 256; i += 64) { const int rel = i - 64; tbl[i] = relb[hb * 257 + (rel > 128 ? 128 : rel) + 128] * LOG2E; }
                cb = relb[hb * 257 + 256] * LOG2E; }
            float m2b = m2a, lb = la;
            const int nhead = head + 8; const bool nA = (it + 1) < 2;
            const size_t nho = ((size_t)(nA ? (nhead >> 2) : (nhead - 16)) * NT + tok0) * 64;
            const bf16* nkb0 = (const bf16*)(kvh + (nA ? KVH_KA : KVH_KB)) + nho; const bf16* nvb0 = (const bf16*)(kvh + (nA ? KVH_VA : KVH_VB)) + nho;
            f32x16 oa0, oa1, ob0, ob1;
#pragma unroll
            for (int r = 0; r < 16; ++r) { oa0[r] = 0.f; oa1[r] = 0.f; ob0[r] = 0.f; ob1[r] = 0.f; }
            for (int dd = 0; dd <= dmax; ++dd) {
                const bool first = (!isA) && dd == 0;
                unsigned klu = (unsigned)(__UINTPTR_TYPE__)kl; asm volatile("" : "+s"(klu));
                asm volatile("s_waitcnt vmcnt(8)" ::: "memory");
                f32x16 s0, s1;
                att_scores(s0, s1, qf0, kl + kro, hh, km, tbl, isA, dd, nslope2, cb, base0, first ? 0.f : m2a);
                att_softmax_pv<true>(s0, s1, oa0, oa1, m2a, la, vl, tr0, first);
                att_scores(s0, s1, qf1, kl + kro, hh, km, tbl, isA, dd, nslope2, cb, base0 + 32, first ? 0.f : m2b);
                __builtin_amdgcn_sched_barrier(0);
                if (dd < dmax) { const bf16* kp = kb0 - (size_t)(64 * (dd + 1)) * 64; ATT_DMAK(kp); }
                else if (it < 3) { ATT_DMAK(nkb0); }
                att_softmax_pv<false>(s0, s1, ob0, ob1, m2b, lb, vl, tr0, first);
                __builtin_amdgcn_sched_barrier(0);
                if (dd < dmax) { const bf16* vp = vb0 - (size_t)(64 * (dd + 1)) * 64; ATT_DMAV(vp); }
                else if (it < 3) { ATT_DMAV(nvb0); }
            }
            if (it < 3) {
                const int nh = head + 8; const bf16* qp = qkv + (size_t)(tok0 + l31) * DIN + ((it + 1) < 2 ? COL_QA + nh * 64 : COL_QB + (nh - 16) * 64) + 8 * hh;
#pragma unroll
                for (int ks = 0; ks < 4; ++ks) { qn0[ks] = __builtin_nontemporal_load((const bf16x8*)(qp + 16 * ks)); qn1[ks] = __builtin_nontemporal_load((const bf16x8*)(qp + (size_t)32 * DIN + 16 * ks)); } }
#pragma unroll
            for (int qh = 0; qh < 2; ++qh) {
                f32x16& o0 = qh ? ob0 : oa0; f32x16& o1 = qh ? ob1 : oa1; float l = qh ? lb : la;
                { const auto rr = __builtin_amdgcn_permlane32_swap(__float_as_uint(l), __float_as_uint(l), false, false); l = __uint_as_float(rr[0]) + __uint_as_float(rr[1]); }
                const float inv = 1.0f / l; float ssq = 0.f;
#pragma unroll
                for (int r = 0; r < 16; ++r) { o0[r] *= inv; o1[r] *= inv; ssq += o0[r] * o0[r] + o1[r] * o1[r]; }
                ssq += __shfl_xor(ssq, 32);
                if (hh == 0) ssqp[head * 64 + 32 * qh + l31] = ssq;
                unsigned char* op = O + (size_t)(tok0 + 32 * qh + l31) * DM + head * 64 + 16 * hh;
#pragma unroll
                for (int dt = 0; dt < 2; ++dt) { const f32x16& ov = dt ? o1 : o0; unsigned d[4];
#pragma unroll
                    for (int r4 = 0; r4 < 4; ++r4) d[r4] = cvt4_fp8(ov[4 * r4] * F8_SO, ov[4 * r4 + 1] * F8_SO, ov[4 * r4 + 2] * F8_SO, ov[4 * r4 + 3] * F8_SO);
                    const auto s02 = __builtin_amdgcn_permlane32_swap(d[0], d[2], false, false), s13 = __builtin_amdgcn_permlane32_swap(d[1], d[3], false, false);
                    u32x4 w; w.x = s02[0]; w.y = s02[1]; w.z = s13[0]; w.w = s13[1];
                    *(u32x4*)(op + 32 * dt) = w; }
            }
        }
        __syncthreads();
        if (tid < 128) { const int g = tid >> 6, q = tid & 63; float sacc = 0.f;
#pragma unroll
            for (int h = 0; h < 16; ++h) sacc += ssqp[(16 * g + h) * 64 + q];
            float* SSQ = (float*)(a.ws + WS_SSQ); SSQ[(size_t)(tok0 + q) * 2 + g] = sacc; }
        __syncthreads();
    }
}

constexpr int P5_ROWB = 528;
__device__ __forceinline__ void p5_norm_router(const Ctx& a, LAS unsigned char* lds, int tid, int lane, int wave) {
    const bf16* x1 = (const bf16*)(a.ws + WS_X1); const float* mod = (const float*)(a.ws + WS_MOD); unsigned char* H = a.ws + WS_H;
    const float* aux = (const float*)(a.ws + WS_AUX);
    const bf16* wrhi = (const bf16*)(a.ws + WS_WRT); const bf16* wrlo = wrhi + 48 * 2048;
    unsigned char* rt = a.ws + WS_ROUTE;
    int* tok_e = (int*)(rt + RT_TOKE); float* tok_w = (float*)(rt + RT_TOKW); int* tok_rank = (int*)(rt + RT_RANK); int* cntWG = (int*)(rt + RT_CNT);
    constexpr int TILE_B = 16 * P5_ROWB, WR_B = 48 * P5_ROWB;
    const int pairi = wave >> 1, odd = wave & 1;
    LAS unsigned char* uh = lds + pairi * (2 * TILE_B);
    LAS unsigned char* ul = uh + TILE_B;
    LAS unsigned char* wh = lds + 4 * 2 * TILE_B;
    LAS unsigned char* wl = wh + WR_B;
    LAS float* up = (LAS float*)(lds + 4 * 2 * TILE_B + 2 * WR_B);
    LAS float* sp = up + 64 * 48;
    LAS float* lg = sp + 64;
    LAS float* rsd = lg + 64 * 48;
    static_assert(4 * 2 * TILE_B + 2 * WR_B + (64 * 48 + 64 + 64 * 48 + 64) * 4 <= MISC_OFF, "P5 LDS map");
    const int tr = lane & 15, kq = lane >> 4;
    const int hrow = lane >> 5, hl = lane & 31;
    for (int blk = blockIdx.x; blk < 256; blk += gridDim.x) {
        const int t0 = blk * 64 + pairi * 16, b = blk >> 6;
        const bf16* xw = x1 + (size_t)(t0 + 8 * odd + hrow) * DM + 8 * hl;
        const float* ap = aux + 1024 + b * DM + 8 * hl;
        const float* shp = mod + (size_t)b * 16384 + 6144 + 8 * hl; unsigned char* hwp = H + (size_t)(t0 + 8 * odd + hrow) * DM + 8 * hl;
        const int wrow0 = wave * 6;
        if (tid < 64) {
            const f32x4* pr = (const f32x4*)((const float*)(a.ws + WS_RSS) + (size_t)(blk * 64 + tid) * 64); f32x4 acc4 = pr[0];
#pragma unroll
            for (int i = 1; i < 16; ++i) acc4 = acc4 + pr[i];
            rsd[tid] = __builtin_amdgcn_rsqf(((acc4[0] + acc4[1]) + (acc4[2] + acc4[3])) * (1.0f / DM) + EPS); }
        __syncthreads();
        {
            f32x4 acc[2];
            acc[0] = (f32x4){0.f, 0.f, 0.f, 0.f}; acc[1] = (f32x4){0.f, 0.f, 0.f, 0.f};
            u32x4 xv[4], wv[6];
#pragma unroll
            for (int i = 0; i < 4; ++i) xv[i] = __builtin_nontemporal_load((const u32x4*)(xw + (size_t)(2 * i) * DM));
#pragma unroll
            for (int i = 0; i < 6; ++i) { const int r = 2 * (wrow0 + i) + hrow; wv[i] = *(const u32x4*)((r < 48 ? wrhi + (size_t)r * 2048 : wrlo + (size_t)(r - 48) * 2048) + 8 * hl); }
            for (int c4 = 0; c4 < 8; ++c4) {
                const f32x4 a0 = *(const f32x4*)(ap + 256 * c4), a1 = *(const f32x4*)(ap + 256 * c4 + 4), sh0 = *(const f32x4*)(shp + 256 * c4), sh1 = *(const f32x4*)(shp + 256 * c4 + 4);
                __syncthreads();
#pragma unroll
                for (int i = 0; i < 4; ++i) { const u32x4 v = xv[i]; const int r = 8 * odd + 2 * i + hrow; const float rs = rsd[pairi * 16 + r];
                    const f32x4 f0 = {bf_lo(v.x), bf_hi(v.x), bf_lo(v.y), bf_hi(v.y)}, f1 = {bf_lo(v.z), bf_hi(v.z), bf_lo(v.w), bf_hi(v.w)};
                    const f32x4 u0 = f0 * a0, u1 = f1 * a1; u32x4 hi, lo;
                    { const f32x4 h0 = (u0 * rs + sh0) * F8_SH, h1 = (u1 * rs + sh1) * F8_SH; u32x2 hw; hw.x = cvt4_fp8(h0[0], h0[1], h0[2], h0[3]); hw.y = cvt4_fp8(h1[0], h1[1], h1[2], h1[3]);
                      *(u32x2*)(hwp + (size_t)(2 * i) * DM + 256 * c4) = hw; }
                    hi.x = cvtpk(u0[0], u0[1]); hi.y = cvtpk(u0[2], u0[3]); hi.z = cvtpk(u1[0], u1[1]); hi.w = cvtpk(u1[2], u1[3]);
                    lo.x = cvtpk(u0[0] - bf_lo(hi.x), u0[1] - bf_hi(hi.x)); lo.y = cvtpk(u0[2] - bf_lo(hi.y), u0[3] - bf_hi(hi.y));
                    lo.z = cvtpk(u1[0] - bf_lo(hi.z), u1[1] - bf_hi(hi.z)); lo.w = cvtpk(u1[2] - bf_lo(hi.w), u1[3] - bf_hi(hi.w));
                    *(LAS u32x4*)(uh + r * P5_ROWB + 16 * hl) = hi; *(LAS u32x4*)(ul + r * P5_ROWB + 16 * hl) = lo; }
#pragma unroll
                for (int i = 0; i < 6; ++i) { const int r = 2 * (wrow0 + i) + hrow; *(LAS u32x4*)(wh + r * P5_ROWB + 16 * hl) = wv[i]; }
                if (c4 < 7) {
#pragma unroll
                    for (int i = 0; i < 4; ++i) xv[i] = __builtin_nontemporal_load((const u32x4*)(xw + (size_t)(2 * i) * DM + 256 * (c4 + 1)));
#pragma unroll
                    for (int i = 0; i < 6; ++i) { const int r = 2 * (wrow0 + i) + hrow; wv[i] = *(const u32x4*)((r < 48 ? wrhi + (size_t)r * 2048 : wrlo + (size_t)(r - 48) * 2048) + 256 * (c4 + 1) + 8 * hl); } }
                __syncthreads();
#pragma unroll 2
                for (int kk = 0; kk < 8; ++kk) {
                    const bf16x8 ahi = *(const LAS bf16x8*)(uh + tr * P5_ROWB + 64 * kk + 16 * kq), alo = *(const LAS bf16x8*)(ul + tr * P5_ROWB + 64 * kk + 16 * kq);
                    if (!odd) {
#pragma unroll
                        for (int c = 0; c < 2; ++c) { const bf16x8 bhi = *(const LAS bf16x8*)(wh + (16 * c + tr) * P5_ROWB + 64 * kk + 16 * kq), blo = *(const LAS bf16x8*)(wl + (16 * c + tr) * P5_ROWB + 64 * kk + 16 * kq);
                            acc[c] = __builtin_amdgcn_mfma_f32_16x16x32_bf16(ahi, bhi, acc[c], 0, 0, 0);
                            acc[c] = __builtin_amdgcn_mfma_f32_16x16x32_bf16(ahi, blo, acc[c], 0, 0, 0);
                            acc[c] = __builtin_amdgcn_mfma_f32_16x16x32_bf16(alo, bhi, acc[c], 0, 0, 0); }
                    } else { const bf16x8 bhi = *(const LAS bf16x8*)(wh + (32 + tr) * P5_ROWB + 64 * kk + 16 * kq), blo = *(const LAS bf16x8*)(wl + (32 + tr) * P5_ROWB + 64 * kk + 16 * kq);
                        acc[0] = __builtin_amdgcn_mfma_f32_16x16x32_bf16(ahi, bhi, acc[0], 0, 0, 0);
                        acc[0] = __builtin_amdgcn_mfma_f32_16x16x32_bf16(ahi, blo, acc[0], 0, 0, 0);
                        acc[0] = __builtin_amdgcn_mfma_f32_16x16x32_bf16(alo, bhi, acc[0], 0, 0, 0); }
                }
            }
            if (!odd) {
#pragma unroll
                for (int c = 0; c < 2; ++c)
#pragma unroll
                    for (int r = 0; r < 4; ++r) up[(pairi * 16 + 4 * kq + r) * 48 + 16 * c + tr] = acc[c][r];
            } else {
#pragma unroll
                for (int r = 0; r < 4; ++r) up[(pairi * 16 + 4 * kq + r) * 48 + 32 + tr] = acc[0][r];
            }
        }
        __syncthreads();
        for (int i = tid; i < 64 * 48; i += 512) { const int tok = i / 48, c = i - tok * 48; lg[i] = rsd[tok] * up[i] + aux[b * 48 + c]; }
        __syncthreads();
        if (tid < 64) {
            const int tt = blk * 64 + tid; const LAS float* L = lg + tid * 48;
            float gl[4]; int gi = 0;
#pragma unroll
            for (int j = 0; j < 4; ++j) gl[j] = L[j];
            float gm = gl[0];
#pragma unroll
            for (int j = 1; j < 4; ++j) if (gl[j] > gm) { gm = gl[j]; gi = j; }
            float den = 0.f;
#pragma unroll
            for (int j = 0; j < 4; ++j) den += __expf(gl[j] - gm);
            const float pg = 1.0f / den;
            float el[8];
#pragma unroll
            for (int i = 0; i < 8; ++i) el[i] = L[4 + 8 * gi + i];
            int i1 = 0; float v1 = el[0];
#pragma unroll
            for (int i = 1; i < 8; ++i) if (el[i] > v1) { v1 = el[i]; i1 = i; }
            int i2 = -1; float v2 = -3.0e38f;
#pragma unroll
            for (int i = 0; i < 8; ++i) if (i != i1 && el[i] > v2) { v2 = el[i]; i2 = i; }
            const float ex = __expf(v2 - v1), w1 = pg / (1.0f + ex), w2 = pg * ex / (1.0f + ex);
            const int e1 = gi * 8 + i1, e2 = gi * 8 + i2;
            const unsigned long long lt = (1ull << lane) - 1ull;
            int r1 = 0, r2 = 0, mycnt = 0;
            for (int e = 0; e < NEXP; ++e) { const unsigned long long m1 = __ballot(e1 == e), m2 = __ballot(e2 == e); const int c1 = __popcll(m1);
                if (e1 == e) r1 = __popcll(m1 & lt); if (e2 == e) r2 = c1 + __popcll(m2 & lt); if (lane == e) mycnt = c1 + __popcll(m2); }
            tok_e[2 * tt] = e1; tok_e[2 * tt + 1] = e2; tok_w[2 * tt] = w1; tok_w[2 * tt + 1] = w2; tok_rank[2 * tt] = r1; tok_rank[2 * tt + 1] = r2;
            if (lane < NEXP) cntWG[blk * NEXP + lane] = mycnt;
        }
        __syncthreads();
    }
}

__device__ __forceinline__ void p6_slots(const Ctx& a, LAS unsigned char* lds, int tid) {
    unsigned char* rt = a.ws + WS_ROUTE;
    const int* tok_e = (const int*)(rt + RT_TOKE); const int* tok_rank = (const int*)(rt + RT_RANK); int* tok_slot = (int*)(rt + RT_SLOT); const int* cntWG = (const int*)(rt + RT_CNT);
    int* rowidx = (int*)(rt + RT_ROWIDX); int* tile_exp = (int*)(rt + RT_TILEEXP); int* ntiles = (int*)(rt + RT_NTILES);
    LAS int* ptot = (LAS int*)lds;
    LAS int* ppre = ptot + 512;
    LAS int* tot = ppre + 512;
    LAS int* pre = tot + 32;
    LAS int* sb = pre + 32;
    for (int blk = blockIdx.x; blk < 256; blk += gridDim.x) {
        { const int e = tid & 31, part = tid >> 5; int st = 0, sp = 0;
            for (int w = part * 16; w < part * 16 + 16; ++w) { const int c = cntWG[w * NEXP + e]; st += c; if (w < blk) sp += c; }
            ptot[part * 32 + e] = st; ppre[part * 32 + e] = sp; }
        __syncthreads();
        if (tid < 32) { int st = 0, sp = 0;
#pragma unroll
            for (int p = 0; p < 16; ++p) { st += ptot[p * 32 + tid]; sp += ppre[p * 32 + tid]; }
            tot[tid] = st; pre[tid] = sp; }
        __syncthreads();
        if (tid == 0) { int s = 0; for (int e = 0; e < NEXP; ++e) { sb[e] = s; s += ((tot[e] + 255) >> 8) << 8; } sb[NEXP] = s; }
        __syncthreads();
        if (tid < 128) { const int tk = blk * 64 + (tid >> 1), j = tid & 1; const int e = tok_e[2 * tk + j]; const int slot = sb[e] + pre[e] + tok_rank[2 * tk + j];
            tok_slot[2 * tk + j] = slot; rowidx[slot] = tk; }
        if (blk < NEXP) { const int e = blk, s0 = sb[e] + tot[e], s1 = sb[e + 1];
            for (int s = s0 + tid; s < s1; s += 512) rowidx[s] = 0;
            for (int g = (sb[e] >> 8) + tid; g < (sb[e + 1] >> 8); g += 512) tile_exp[g] = e; }
        if (blk == 0 && tid == 0) ntiles[0] = sb[NEXP] >> 8;
        if (blk == 0 && tid <= NEXP) ((int*)(rt + RT_TSTART))[tid] = sb[tid] >> 8;
        __syncthreads();
    }
}

__device__ __forceinline__ void p9_final(const Ctx& a, int lane, int wave) {
    const bf16* X = (const bf16*)(a.ws + WS_X1); float* OUT = a.out; const float* gf = a.in[I_GFIN]; const float* mod = (const float*)(a.ws + WS_MOD); const unsigned char* Y = a.ws + WS_Y;
    unsigned char* rt = a.ws + WS_ROUTE; const int* tok_slot = (const int*)(rt + RT_SLOT); const float* tok_w = (const float*)(rt + RT_TOKW);
    const int gw = blockIdx.x * 8 + wave, NGW = gridDim.x * 8;
    for (int grp = gw; grp < NT / 8; grp += NGW) {
        const int row0 = grp * 8, b = row0 >> 12;
        f32x4 A[8], Bv[8], G2[8];
#pragma unroll
        for (int j = 0; j < 8; ++j) { const int k = 4 * lane + 256 * j; const f32x4 gg = *(const f32x4*)(gf + k), sc = *(const f32x4*)(mod + (size_t)b * 16384 + 12288 + 2048 + k);
            A[j] = gg * (1.0f + sc); Bv[j] = *(const f32x4*)(mod + (size_t)b * 16384 + 12288 + k); G2[j] = *(const f32x4*)(mod + (size_t)b * 16384 + 10240 + k); }
        const int lr = lane & 7; const int2 sl = *(const int2*)(tok_slot + 2 * (row0 + lr)); const f32x2_t wl = *(const f32x2_t*)(tok_w + 2 * (row0 + lr));
        for (int r = 0; r < 8; r += 2) {
            u32x2 xb[2][8]; unsigned ya[2][8], yb[2][8]; float w1[2], w2[2];
#pragma unroll
            for (int h = 0; h < 2; ++h) { const int t = row0 + r + h;
                const int s1 = __builtin_amdgcn_readlane(sl.x, r + h), s2 = __builtin_amdgcn_readlane(sl.y, r + h);
                w1[h] = __uint_as_float(__builtin_amdgcn_readlane(__float_as_uint(wl.x), r + h)) * (1.0f / F8_SY); w2[h] = __uint_as_float(__builtin_amdgcn_readlane(__float_as_uint(wl.y), r + h)) * (1.0f / F8_SY);
                const bf16* xr = X + (size_t)t * DM + 4 * lane; const unsigned char* y1 = Y + (size_t)s1 * DM + 4 * lane; const unsigned char* y2 = Y + (size_t)s2 * DM + 4 * lane;
#pragma unroll
                for (int j = 0; j < 8; ++j) { xb[h][j] = __builtin_nontemporal_load((const u32x2*)(xr + 256 * j)); ya[h][j] = __builtin_nontemporal_load((const unsigned*)(y1 + 256 * j)); yb[h][j] = __builtin_nontemporal_load((const unsigned*)(y2 + 256 * j)); } }
#pragma unroll
            for (int h = 0; h < 2; ++h) { float* outr = OUT + (size_t)(row0 + r + h) * DM + 4 * lane; f32x4 v[8]; float s = 0.f;
#pragma unroll
                for (int j = 0; j < 8; ++j) { const u32x2 x2 = xb[h][j]; const f32x4 xv = {bf_lo(x2.x), bf_hi(x2.x), bf_lo(x2.y), bf_hi(x2.y)};
                    const f32x2_t p0 = __builtin_amdgcn_cvt_pk_f32_fp8((int)ya[h][j], false), p1 = __builtin_amdgcn_cvt_pk_f32_fp8((int)ya[h][j], true), q0 = __builtin_amdgcn_cvt_pk_f32_fp8((int)yb[h][j], false), q1 = __builtin_amdgcn_cvt_pk_f32_fp8((int)yb[h][j], true);
                    f32x4 yv; yv[0] = w1[h] * p0[0] + w2[h] * q0[0]; yv[1] = w1[h] * p0[1] + w2[h] * q0[1]; yv[2] = w1[h] * p1[0] + w2[h] * q1[0]; yv[3] = w1[h] * p1[1] + w2[h] * q1[1];
                    v[j] = xv + G2[j] * yv; s += (v[j][0] * v[j][0] + v[j][1] * v[j][1]) + (v[j][2] * v[j][2] + v[j][3] * v[j][3]); }
                const float rstd = __builtin_amdgcn_rsqf(wave_sum(s) * (1.0f / DM) + EPS);
#pragma unroll
                for (int j = 0; j < 8; ++j) __builtin_nontemporal_store(v[j] * rstd * A[j] + Bv[j], (f32x4*)(outr + 256 * j)); }
        }
    }
}

constexpr int NPH = 10;
__global__ void __launch_bounds__(512, 2) hybrid_fwd(Args kargs) {
    extern __shared__ __attribute__((aligned(16))) unsigned char lds_raw[];
    LAS unsigned char* lds = (LAS unsigned char*)lds_raw;
    const int tid = threadIdx.x, lane = tid & 63, wave = __builtin_amdgcn_readfirstlane(tid >> 6);
    volatile LAS unsigned* MISC = (volatile LAS unsigned*)(lds + MISC_OFF);
    if (tid < 4) MISC[tid] = 0u;
    __syncthreads();
    const int lo = kargs.ph_lo, hi = kargs.ph_hi;
    Ctx args; args.out = kargs.out; args.ws = kargs.ws;
    XcdBarrier bar; bar.bar = (unsigned*)(args.ws + WS_CTL); bar.x = 0; bar.st = nullptr;
    if (hi - lo > 1) bar = xcd_barrier_post((unsigned*)(args.ws + WS_CTL), MISC);
#define IN(k) (lo <= (k) && (k) < hi)
#define REPS(k) (((REPEAT_MASK >> (k)) & 1) ? 2 : 1)
#define SEAM(k) do { if (IN(k) && IN((k) + 1)) xcd_barrier(bar); } while (0)

    if (IN(0)) for (int rep = 0; rep < REPS(0); ++rep) { p0_mod(args, lds, tid, lane, wave); p0_convert(args, lds, tid, lane, wave); __syncthreads(); }
    SEAM(0);
    if (IN(1)) for (int rep = 0; rep < REPS(1); ++rep) { p1_norm(args, lane, wave); }
    SEAM(1);
    if (IN(2)) for (int rep = 0; rep < REPS(2); ++rep) {
        pg8::DenseOrder S; S.init(args.ws + WS_H, args.ws + WS_WIN, NT, DIN, DM, (int)gridDim.x, (int)blockIdx.x);
        pg8::EpiQKV E{(bf16*)(args.ws + WS_QKV), (bf16*)(args.ws + WS_KVH)};
        { const int G = (int)gridDim.x, rem = S.nwg % G;
          if (rem != 0 && (int)blockIdx.x >= rem) convert_items(args, lds, lane, wave, CV_UP_TAIL, CV_DN0, ((int)blockIdx.x - rem) * 8 + wave, (G - rem) * 8);
          else if (rem == 0) convert_items(args, lds, lane, wave, CV_UP_TAIL, CV_DN0, (int)blockIdx.x * 8 + wave, G * 8);
          __syncthreads(); }
        pg8::gemm_phase<pg8::EpiQKV, pg8::DenseOrder, false>(lds, DM, S, E);
    }
    SEAM(2);
    if (IN(3)) for (int rep = 0; rep < REPS(3); ++rep) { p3_attn(args, lds, tid, lane, wave); }
    SEAM(3);
    if (IN(4)) for (int rep = 0; rep < REPS(4); ++rep) {
        pg8::DenseOrder S; S.init(args.ws + WS_O, args.ws + WS_WOUT, NT, DM, DM / 2, (int)gridDim.x, (int)blockIdx.x);
        pg8::EpiRes E{args.in[I_X], (bf16*)(args.ws + WS_X1), (const float*)(args.ws + WS_MOD), (const float*)(args.ws + WS_SSQ), (float*)(args.ws + WS_RSS)};
        { const int G = (int)gridDim.x; if ((int)blockIdx.x >= G / 2) convert_items(args, lds, lane, wave, CV_G_P4, CV_UP0, ((int)blockIdx.x - G / 2) * 8 + wave, (G - G / 2) * 8); __syncthreads(); }
        {
            LAS float* tab = (LAS float*)(lds + pg8::EpiRes::TAB_OFF); const float* SSQ = (const float*)(args.ws + WS_SSQ); pg8::Unit u;
            for (int i = 0; i < 8 && S.next(i, u); ++i)
                if (tid < 256) { const float qa = SSQ[(size_t)(u.pm * 256 + tid) * 2], qb = SSQ[(size_t)(u.pm * 256 + tid) * 2 + 1];
                    const float rA = __builtin_amdgcn_rsqf(qa * (1.0f / 1024.0f) + EPS), rB = __builtin_amdgcn_rsqf(qb * (1.0f / 1024.0f) + EPS);
                    tab[(i * 256 + tid) * 2] = rA / rB; tab[(i * 256 + tid) * 2 + 1] = rB * (1.0f / (F8_SO * F8_SWO)); }
            __syncthreads();
        }
        pg8::gemm_phase<pg8::EpiRes, pg8::DenseOrder, false, true>(lds, DM / 2, S, E);
    }
    SEAM(4);
    if (IN(5)) for (int rep = 0; rep < REPS(5); ++rep) { p5_norm_router(args, lds, tid, lane, wave); }
    SEAM(5);
    if (IN(6)) { p6_slots(args, lds, tid); }
    SEAM(6);
    if (IN(7)) for (int rep = 0; rep < REPS(7); ++rep) {
        unsigned char* rt = args.ws + WS_ROUTE;
        pg8::GroupedOrder S; S.A = (const char*)(args.ws + WS_H); S.Bt = (const char*)(args.ws + WS_WGU); S.estride = (size_t)1024 * DM; S.K = DM / 2;
        S.rowidx = (const int*)(rt + RT_ROWIDX);
        const int ntiles = *(const int*)(rt + RT_NTILES);
        pg8::EpiGU E{args.ws + WS_ACT};
        { const int G = (int)gridDim.x; const int* ts = (const int*)(rt + RT_TSTART);
          const int nlab = (G % 8 == 0) ? 8 : 1, Gx = G / nlab, myx = nlab == 8 ? ((int)blockIdx.x & 7) : 0, myj = nlab == 8 ? ((int)blockIdx.x >> 3) : (int)blockIdx.x;
          int numax = 0;
          for (int x = 0; x < nlab; ++x) { int nu = 0; for (int e = x; e < NEXP; e += nlab) nu += (ts[e + 1] - ts[e]) * 4; numax = nu > numax ? nu : numax; }
          const int maxc = (numax + Gx - 1) / Gx;
          int nconv = 0, myidx = -1;
          for (int x = 0; x < nlab; ++x) { int nu = 0; for (int e = x; e < NEXP; e += nlab) nu += (ts[e + 1] - ts[e]) * 4;
              int nfull = nu - Gx * (maxc - 1); nfull = nfull < 0 ? 0 : (nfull > Gx ? Gx : nfull);
              if (x == myx && myj >= nfull) myidx = nconv + (myj - nfull);
              nconv += Gx - nfull; }
          if (nconv == 0) convert_items(args, lds, lane, wave, CV_DN_TAIL, CV_ALL, (int)blockIdx.x * 8 + wave, G * 8);
          else if (myidx >= 0) convert_items(args, lds, lane, wave, CV_DN_TAIL, CV_ALL, myidx * 8 + wave, nconv * 8);
          __syncthreads(); }
        S.build(lds, (const int*)(rt + RT_TSTART), 4, (int)gridDim.x, (int)blockIdx.x);
        pg8::gemm_phase<pg8::EpiGU, pg8::GroupedOrder, true, true>(lds, DM / 2, S, E);
    }
    SEAM(7);
    if (IN(8)) for (int rep = 0; rep < REPS(8); ++rep) {
        unsigned char* rt = args.ws + WS_ROUTE;
        pg8::GroupedOrder S; S.A = (const char*)(args.ws + WS_ACT); S.Bt = (const char*)(args.ws + WS_WD); S.estride = (size_t)DM * DE; S.K = DE / 2;
        S.rowidx = nullptr; S.build(lds, (const int*)(rt + RT_TSTART), 8, (int)gridDim.x, (int)blockIdx.x);
        pg8::EpiY E{args.ws + WS_Y};
        pg8::gemm_phase<pg8::EpiY, pg8::GroupedOrder, false, true>(lds, DE / 2, S, E);
    }
    SEAM(8);
    if (IN(9)) { p9_final(args, lane, wave); }
#undef IN
#undef SEAM
}

extern "C" void kernel_launch(void* const* d_in, const int* in_sizes, int n_in, void* d_out, int out_size, void* d_ws, size_t ws_size, hipStream_t stream) {
    static int grid = 0;
    if (grid == 0) {
        if (n_in != 22 || out_size != NT * DM || ws_size < WS_END) { fprintf(stderr, "kernel_launch: unexpected shapes (n_in %d, out %d, ws %zu)\n", n_in, out_size, ws_size); grid = -1; return; }
        int dev = 0, cus = 0, per_cu = 0;
        if (hipGetDevice(&dev) != hipSuccess || hipDeviceGetAttribute(&cus, hipDeviceAttributeMultiprocessorCount, dev) != hipSuccess) { grid = -1; return; }
        if (hipFuncSetAttribute((const void*)hybrid_fwd, hipFuncAttributeMaxDynamicSharedMemorySize, LDS_BYTES) != hipSuccess) { fprintf(stderr, "kernel_launch: hipFuncSetAttribute failed\n"); grid = -1; return; }
        if (hipOccupancyMaxActiveBlocksPerMultiprocessor(&per_cu, (const void*)hybrid_fwd, 512, LDS_BYTES) != hipSuccess || per_cu < 1) { fprintf(stderr, "kernel_launch: occupancy query says %d\n", per_cu); }
        (void)hipGetLastError();
        grid = cus;
    }
    if (grid < 0) return;
    (void)hipMemsetAsync((char*)d_ws + WS_CTL, 0, CTL_ZERO_BYTES, stream);
    Args a{};
    for (int i = 0; i < 22; ++i) a.in[i] = (const float*)d_in[i];
    a.out = (float*)d_out; a.ws = (unsigned char*)d_ws;
#if MK_PER_PHASE
    for (int p = 0; p < NPH; ++p) { a.ph_lo = p; a.ph_hi = p + 1; hipLaunchKernelGGL(hybrid_fwd, dim3(grid), dim3(512), LDS_BYTES, stream, a); }
#else
    if (PROBE_EXTRA_PHASE >= 0) {
        a.ph_lo = 0; a.ph_hi = PROBE_EXTRA_PHASE + 1; hipLaunchKernelGGL(hybrid_fwd, dim3(grid), dim3(512), LDS_BYTES, stream, a);
        (void)hipMemsetAsync((char*)d_ws + WS_CTL, 0, CTL_ZERO_BYTES, stream);
        a.ph_lo = PROBE_EXTRA_PHASE; a.ph_hi = PROBE_EXTRA_PHASE + 1; hipLaunchKernelGGL(hybrid_fwd, dim3(grid), dim3(512), LDS_BYTES, stream, a);
        if (PROBE_EXTRA_PHASE + 1 < NPH) { a.ph_lo = PROBE_EXTRA_PHASE + 1; a.ph_hi = NPH; hipLaunchKernelGGL(hybrid_fwd, dim3(grid), dim3(512), LDS_BYTES, stream, a); }
    } else { a.ph_lo = 0; a.ph_hi = NPH; hipLaunchKernelGGL(hybrid_fwd, dim3(grid), dim3(512), LDS_BYTES, stream, a); }
#endif
}
```

```cpp
#include <hip/hip_runtime.h>
#include <cstdio>
#include <cstdint>

#ifndef MK_PER_PHASE
#define MK_PER_PHASE 0
#endif

#ifndef PROBE_EXTRA_PHASE
#define PROBE_EXTRA_PHASE -1
#endif
#ifndef EPI_REPS
#define EPI_REPS 1
#endif
#ifndef REPEAT_MASK
#define REPEAT_MASK 0
#endif
#define GAS __attribute__((address_space(1)))
#define LAS __attribute__((address_space(3)))
typedef unsigned short bf16;
typedef short bf16x8 __attribute__((ext_vector_type(8)));
typedef short s16x4 __attribute__((ext_vector_type(4)));
typedef float f32x4 __attribute__((ext_vector_type(4)));
typedef float f32x16 __attribute__((ext_vector_type(16)));
typedef unsigned u32x4 __attribute__((ext_vector_type(4)));
typedef unsigned u32x2 __attribute__((ext_vector_type(2)));
typedef float f32x2_t __attribute__((ext_vector_type(2)));
typedef __bf16 bf16x2_t __attribute__((ext_vector_type(2)));

constexpr int DM = 2048, NB = 4, SEQ = 4096, NT = NB * SEQ, DIN = 4608, NEXP = 32, DE = 512;
constexpr int COL_QA = 0, COL_KA = 1024, COL_VA = 1280, COL_QB = 1536, COL_KB = 2560, COL_VB = 3584;
constexpr int MAXTILES = 160, MAXSLOTS = MAXTILES * 256;
constexpr float EPS = 1e-6f, LOG2E = 1.4426950408889634f;

constexpr size_t MiB = 1u << 20;
constexpr size_t WS_CTL = 0, CTL_ZERO_BYTES = 16384;
constexpr size_t WS_MOD = 1 * MiB;
constexpr size_t WS_ROUTE = 2 * MiB;
constexpr size_t RT_TOKE = 0, RT_TOKW = 131072, RT_RANK = 262144, RT_SLOT = 393216, RT_CNT = 524288, RT_ROWIDX = 557056, RT_TILEEXP = 720896, RT_NTILES = 724992, RT_TSTART = 729088;
constexpr size_t WS_AUX = 3 * MiB;
constexpr size_t WS_SSQ = 3 * MiB + 512 * 1024;
constexpr size_t WS_WRT = 4 * MiB;
constexpr size_t WS_WIN = 5 * MiB;
constexpr size_t WS_WOUT = 23 * MiB;
constexpr size_t WS_WGU = 32 * MiB;
constexpr size_t WS_WD = 160 * MiB;
constexpr size_t WS_H = 224 * MiB;
constexpr size_t WS_QKV = 288 * MiB;
constexpr size_t WS_O = 432 * MiB;
constexpr size_t WS_Y = 288 * MiB;
constexpr size_t WS_ACT = 448 * MiB;
constexpr size_t WS_X1 = 496 * MiB;
constexpr size_t WS_KVH = 560 * MiB;
constexpr size_t KVH_KA = 0, KVH_VA = 8 * MiB, KVH_KB = 16 * MiB, KVH_VB = 48 * MiB;
constexpr size_t WS_RSS = 640 * MiB;
constexpr size_t WS_END = 644 * MiB;

constexpr int RING_BYTES = 131072;
constexpr int MISC_OFF = 151552;
constexpr int LDS_BYTES = 155648;

__device__ __forceinline__ unsigned cvtpk(float lo, float hi) { f32x2_t v = {lo, hi}; bf16x2_t b = __builtin_convertvector(v, bf16x2_t); return __builtin_bit_cast(unsigned, b); }
__device__ __forceinline__ unsigned cvt4_fp8(float a, float b, float c, float d) {
    a = __builtin_fminf(__builtin_fmaxf(a, -448.f), 448.f); b = __builtin_fminf(__builtin_fmaxf(b, -448.f), 448.f);
    c = __builtin_fminf(__builtin_fmaxf(c, -448.f), 448.f); d = __builtin_fminf(__builtin_fmaxf(d, -448.f), 448.f);
    int r = 0; r = __builtin_amdgcn_cvt_pk_fp8_f32(a, b, r, false); r = __builtin_amdgcn_cvt_pk_fp8_f32(c, d, r, true); return (unsigned)r; }
constexpr float F8_SH = 8.0f, F8_SWGU = 1024.0f, F8_SACT = 8.0f, F8_SWD = 512.0f, F8_SY = 32.0f, F8_SO = 64.0f, F8_SWO = 1024.0f;
__device__ __forceinline__ float bf_lo(unsigned u) { return __uint_as_float(u << 16); }
__device__ __forceinline__ float bf_hi(unsigned u) { return __uint_as_float(u & 0xffff0000u); }
__device__ __forceinline__ float wave_sum(float v) {
#pragma unroll
    for (int o = 1; o < 64; o <<= 1) v += __shfl_xor(v, o);
    return v;
}
#define LDS_WAIT() asm volatile("s_waitcnt lgkmcnt(0)" ::: "memory")

#define XB_TMO      128
#define XB_XCNT(j)  (256  + 64 * (j))
#define XB_XSUB(j)  (1280 + 64 * (j))
#define XB_XGEN(j)  (2304 + 64 * (j))
#define XB_TOP      3328
#define XB_TOPGEN   3392
#define XCD_BAR_WORDS 3456
#define XB_SPIN_CAP (1u << 18)

__device__ __forceinline__ unsigned xb_ld(unsigned* p)              { return __hip_atomic_load(p, __ATOMIC_RELAXED, __HIP_MEMORY_SCOPE_AGENT); }
__device__ __forceinline__ unsigned xb_add(unsigned* p, unsigned v) { return __hip_atomic_fetch_add(p, v, __ATOMIC_RELAXED, __HIP_MEMORY_SCOPE_AGENT); }
__device__ __forceinline__ unsigned xb_xcc_id() { return (unsigned)__builtin_amdgcn_s_getreg((3 << 11) | 20) & 0xFu; }
#define XB_SPIN(cond, bar) do { unsigned _sp = 0; while (cond) { __builtin_amdgcn_s_sleep(1); \
    if ((++_sp & 255u) == 0u) { if (xb_ld(&(bar)[XB_TMO])) break; if (_sp > XB_SPIN_CAP) { atomicAdd(&(bar)[XB_TMO], 1u); break; } } } } while (0)

struct XcdBarrier { unsigned* bar; unsigned x; volatile LAS unsigned* st; };

__device__ __forceinline__ XcdBarrier xcd_barrier_post(unsigned* bar, volatile LAS unsigned* st) {
    XcdBarrier b; b.bar = bar; b.x = xb_xcc_id(); b.st = st;
    if (threadIdx.x == 0) (void)xb_add(&bar[XB_XCNT(b.x)], 1u);
    return b;
}
__device__ __forceinline__ void xcd_barrier_complete(unsigned* bar, unsigned x, unsigned& nloc, unsigned& nx) {
    const unsigned G = gridDim.x * gridDim.y * gridDim.z;
    unsigned sum, cnt, mine, sp = 0u;
    for (;;) {
        sum = 0u; cnt = 0u; mine = 0u;
#pragma unroll
        for (unsigned j = 0; j < 16; ++j) { const unsigned c = xb_ld(&bar[XB_XCNT(j)]); sum += c; cnt += (c > 0u) ? 1u : 0u; mine = (j == x) ? c : mine; }
        if (sum == G) break;
        __builtin_amdgcn_s_sleep(1);
        if ((++sp & 255u) == 0u) { if (xb_ld(&bar[XB_TMO])) break; if (sp > XB_SPIN_CAP) { atomicAdd(&bar[XB_TMO], 1u); break; } }
    }
    nloc = mine > 0u ? mine : 1u; nx = cnt > 0u ? cnt : 1u;
}
__device__ __forceinline__ void xcd_barrier(const XcdBarrier& b) {
    asm volatile("s_waitcnt vmcnt(0)" ::: "memory");
    __syncthreads();
    if (threadIdx.x == 0) {
        unsigned* bar = b.bar;
        __builtin_amdgcn_s_waitcnt(0);
        unsigned nloc = b.st[0], nx = b.st[1];
        if (nloc == 0u) { xcd_barrier_complete(bar, b.x, nloc, nx); b.st[0] = nloc; b.st[1] = nx; }
        const unsigned old = xb_add(&bar[XB_XSUB(b.x)], 1u);
        const unsigned gen = old / nloc;
        if (old + 1u == (gen + 1u) * nloc) {
            __builtin_amdgcn_fence(__ATOMIC_RELEASE, "agent");
            asm volatile("s_waitcnt vmcnt(0)" ::: "memory");
            const unsigned og = xb_add(&bar[XB_TOP], 1u);
            const unsigned tg = og / nx;
            if (og + 1u == (tg + 1u) * nx) xb_add(&bar[XB_TOPGEN], 1u);
            else XB_SPIN(xb_ld(&bar[XB_TOPGEN]) == tg, bar);
            __builtin_amdgcn_fence(__ATOMIC_ACQUIRE, "agent");
            xb_add(&bar[XB_XGEN(b.x)], 1u);
            asm volatile("s_waitcnt vmcnt(0)" ::: "memory");
        } else {
            XB_SPIN(xb_ld(&bar[XB_XGEN(b.x)]) == gen, bar);
            __builtin_amdgcn_fence(__ATOMIC_ACQUIRE, "agent");
            asm volatile("s_waitcnt vmcnt(0)" ::: "memory");
        }
    }
    __syncthreads();
}

namespace pg8 {
constexpr int BM = 256, BK = 64, HALF = 128, HTB = HALF * BK * 2, STAGE_BYTES = 8 * HTB, NXCD = 8, WGM = 8;
__host__ __device__ __forceinline__ int lds_byte(int r, int c) { const int st = (r >> 4) * 2 + (c >> 5), rr = r & 15, cc = c & 31, ob = rr * 64 + cc * 2; return st * 1024 + (ob ^ (((ob >> 9) & 1) << 5)); }
__host__ __device__ __forceinline__ void stage_rc(int b, int& R, int& C) { const int st = b / 1024, sb = b % 1024, swz = sb ^ (((sb >> 9) & 1) << 5); R = (st >> 1) * 16 + swz / 64; C = (st & 1) * 32 + (swz % 64) / 2; }
__host__ __device__ __forceinline__ int perm32(int rho) { const int n = rho >> 4, i = rho & 15; return 8 * (i >> 2) + 4 * n + (i & 3); }

struct Unit { int pm, pn, e; };

struct DenseOrder {
    const char* A; const char* Bt; int K; int nM, nN, nwg, G, c;
    __device__ __forceinline__ void init(const void* A_, const void* Bt_, int M, int N, int K_, int G_, int c_) { A = (const char*)A_; Bt = (const char*)Bt_; K = K_; nM = M / BM; nN = N / BM; nwg = nM * nN; G = G_; c = c_; }
    __device__ __forceinline__ bool next(int i, Unit& u) const {
        const long L = (long)i * G + c; if (L >= nwg) return false;
        int wgid = (int)L; { const int q = nwg / NXCD, r = nwg % NXCD, xcd = wgid % NXCD, off = wgid / NXCD; wgid = (xcd < r ? xcd * (q + 1) : r * (q + 1) + (xcd - r) * q) + off; }
        const int nig = WGM * nN, gid = wgid / nig, fm = gid * WGM, gsz = (nM - fm) < WGM ? (nM - fm) : WGM;
        u.pm = fm + ((wgid % nig) % gsz); u.pn = (wgid % nig) / gsz; u.e = 0; return true;
    }
    __device__ __forceinline__ const char* a_ptr(const Unit& u) const { return A + (size_t)u.pm * ((size_t)BM * K * 2); }
    __device__ __forceinline__ const char* b_ptr(const Unit& u) const { return Bt + (size_t)u.pn * ((size_t)BM * K * 2); }
    __device__ __forceinline__ const int* rows(const Unit&) const { return nullptr; }
};
struct GroupedOrder {
    const char* A; const char* Bt; size_t estride; int K; const int* rowidx; const LAS int* ulist;
    static constexpr int GO_MAXU = 48, LIST_OFF = 131072;
    __device__ __forceinline__ void build(LAS unsigned char* lds, const int* tstart, int nN, int G, int c) {
        LAS int* L = (LAS int*)(lds + LIST_OFF); ulist = L;
        if (threadIdx.x < GO_MAXU) {
            const int i = threadIdx.x; int Gx, x, j, nlab;
            if (G % 8 == 0) { Gx = G >> 3; x = c & 7; j = c >> 3; nlab = 8; } else { Gx = G; x = 0; j = c; nlab = 1; }
            const int q = j + Gx * i; int tq = q / nN; const int pn = q - tq * nN; int pm = 0, ee = 0, ok = 0;
            for (int e = x; e < NEXP; e += nlab) { const int s0 = tstart[e], cnt = tstart[e + 1] - s0; if (tq < cnt) { pm = s0 + tq; ee = e; ok = 1; break; } tq -= cnt; }
            L[4 * i] = pm; L[4 * i + 1] = pn; L[4 * i + 2] = ee; L[4 * i + 3] = ok;
        }
        __syncthreads();
    }
    __device__ __forceinline__ bool next(int i, Unit& u) const {
        if (i >= GO_MAXU) return false;
        const LAS int* p = ulist + 4 * i; u.pm = p[0]; u.pn = p[1]; u.e = p[2]; return p[3] != 0;
    }
    __device__ __forceinline__ const char* a_ptr(const Unit& u) const { return rowidx ? A : A + (size_t)u.pm * ((size_t)BM * K * 2); }
    __device__ __forceinline__ const char* b_ptr(const Unit& u) const { return Bt + (size_t)u.e * estride + (size_t)u.pn * ((size_t)BM * K * 2); }
    __device__ __forceinline__ const int* rows(const Unit& u) const { return rowidx + u.pm * BM; }
};

typedef int v4i_t __attribute__((ext_vector_type(4)));
typedef int v8i_t __attribute__((ext_vector_type(8)));
template <class Epi, class Sched, bool GATHER, bool F8 = false>
__device__ __forceinline__ void gemm_phase(LAS unsigned char* lds, const int K, const Sched& S, const Epi& E) {
    const int tid = threadIdx.x, wid = __builtin_amdgcn_readfirstlane(tid >> 6), lane = tid & 63, wr = wid >> 2, wc = wid & 3, fr = lane & 15, fq = lane >> 4;
    const int nt = K / BK;
    unsigned voffA[2], voffB[2], rA[2], cA2[2];
#pragma unroll
    for (int i = 0; i < 2; ++i) { int R, C; stage_rc(tid * 16 + i * 8192, R, C); const int Rb = Epi::PERM ? ((R & ~31) + perm32(R & 31)) : R;
        voffA[i] = (unsigned)(R * K + C) * 2u; voffB[i] = (unsigned)(Rb * K + C) * 2u; rA[i] = (unsigned)R; cA2[i] = (unsigned)C * 2u; }
    const size_t kstep = (size_t)(BK * 2);
    const size_t hstep = (size_t)HALF * K * 2;
    const unsigned ldsw = (unsigned)wid * 1024u;
    const int aoff = lds_byte(wr * 64 + fr, fq * 8), boff = lds_byte(wc * 32 + fr, fq * 8);
#define PG8_SA(b, h) (((b) * 2 + (h)) * HTB)
#define PG8_SB(b, h) ((4 + (b) * 2 + (h)) * HTB)
#define PG8_STAGE(bufoff, gbase, voff) do { _Pragma("unroll") for (int _i = 0; _i < 2; ++_i) \
        __builtin_amdgcn_global_load_lds((const unsigned*)((const char*)(gbase) + (voff)[_i]), (LAS unsigned*)(lds + (bufoff) + ldsw + _i * 8192), 16, 0, 0); } while (0)
#define PG8_STAGE_A(bufoff, base, h, GV) do { if constexpr (GATHER) { PG8_STAGE(bufoff, base, (GV)[h]); } else { PG8_STAGE(bufoff, (base) + (h) * hstep, voffA); } } while (0)
#define PG8_LD8(p) __builtin_shufflevector(*(const LAS v4i_t*)(p), *(const LAS v4i_t*)((p) + 1024), 0, 1, 2, 3, 4, 5, 6, 7)
#define PG8_LDA(dst, b, h) do { _Pragma("unroll") for (int m = 0; m < 4; ++m) { if constexpr (F8) dst##8[m] = PG8_LD8(lds + PG8_SA(b, h) + aoff + m * 2048); else { \
        _Pragma("unroll") for (int k = 0; k < 2; ++k) dst[m][k] = *(const LAS bf16x8*)(lds + PG8_SA(b, h) + aoff + m * 2048 + k * 1024); } } } while (0)
#define PG8_LDB(dst, b, h) do { _Pragma("unroll") for (int n = 0; n < 2; ++n) { if constexpr (F8) dst##8[n] = PG8_LD8(lds + PG8_SB(b, h) + boff + n * 2048); else { \
        _Pragma("unroll") for (int k = 0; k < 2; ++k) dst[n][k] = *(const LAS bf16x8*)(lds + PG8_SB(b, h) + boff + n * 2048 + k * 1024); } } } while (0)
#define PG8_MMA(ai, bj, At, Bt) do { __builtin_amdgcn_s_setprio(1); _Pragma("unroll") for (int m = 0; m < 4; ++m) _Pragma("unroll") for (int n = 0; n < 2; ++n) { \
        if constexpr (F8) { \
            asm volatile("v_mfma_scale_f32_16x16x128_f8f6f4 %0, %1, %2, %0, %3, %3 op_sel_hi:[0,0,0]" : "+v"(acc[ai][bj][m][n]) : "v"(Bt##8[n]), "v"(At##8[m]), "v"(f8one)); } \
        else { _Pragma("unroll") for (int k = 0; k < 2; ++k) acc[ai][bj][m][n] = __builtin_amdgcn_mfma_f32_16x16x32_bf16(Bt[n][k], At[m][k], acc[ai][bj][m][n], 0, 0, 0); } } \
        __builtin_amdgcn_s_setprio(0); } while (0)
#define PG8_WAIT_V(n) asm volatile("s_waitcnt vmcnt(" #n ")" ::: "memory")
#define PG8_WAIT_L(n) asm volatile("s_waitcnt lgkmcnt(" #n ")" ::: "memory")
#define PG8_BAR __builtin_amdgcn_s_barrier()
#define PG8_SCHED __builtin_amdgcn_sched_barrier(0)
#define PG8_ROWS(GV, u) do { const int* _rp = S.rows(u); _Pragma("unroll") for (int _h = 0; _h < 2; ++_h) _Pragma("unroll") for (int _i = 0; _i < 2; ++_i) \
        (GV)[_h][_i] = (unsigned)_rp[128 * _h + rA[_i]] * (unsigned)(K * 2) + cA2[_i]; } while (0)
    Unit cur, nxt; int ui = 0;
    if (!S.next(0, cur)) return;
    f32x4 acc[2][2][4][2];
#pragma unroll
    for (int a = 0; a < 2; ++a)
#pragma unroll
        for (int b = 0; b < 2; ++b)
#pragma unroll
            for (int m = 0; m < 4; ++m)
#pragma unroll
                for (int n = 0; n < 2; ++n) acc[a][b][m][n] = (f32x4){0.f, 0.f, 0.f, 0.f};
    const int f8one = 0x7f7f7f7f;
    bf16x8 At[4][2], B0[2][2], B1[2][2]; v8i_t At8[4], B08[2], B18[2];
    unsigned cv[2][2] = {{0u, 0u}, {0u, 0u}}, nv[2][2] = {{0u, 0u}, {0u, 0u}};
    const char* cA = S.a_ptr(cur); const char* cB = S.b_ptr(cur);
    if constexpr (GATHER) PG8_ROWS(cv, cur);
    PG8_STAGE(PG8_SB(0, 0), cB, voffB); PG8_STAGE(PG8_SB(0, 1), cB + hstep, voffB); PG8_STAGE_A(PG8_SA(0, 0), cA, 0, cv); PG8_STAGE_A(PG8_SA(0, 1), cA, 1, cv);
    if (wr == 1) PG8_BAR;
    PG8_WAIT_V(2); PG8_BAR;
    PG8_STAGE(PG8_SB(1, 0), cB + kstep, voffB); PG8_STAGE_A(PG8_SA(1, 0), cA + kstep, 0, cv); PG8_STAGE(PG8_SB(1, 1), cB + hstep + kstep, voffB);
    PG8_WAIT_V(6); PG8_BAR;
    for (;;) {
        const bool has_next = S.next(ui + 1, nxt);
        const char* nA = has_next ? S.a_ptr(nxt) : cA; const char* nB = has_next ? S.b_ptr(nxt) : cB;
        if constexpr (GATHER) { if (has_next) PG8_ROWS(nv, nxt); else {
#pragma unroll
            for (int h = 0; h < 2; ++h)
#pragma unroll
                for (int i = 0; i < 2; ++i) nv[h][i] = cv[h][i]; } }
        for (int t = 0; t < nt; t += 2) {
            const bool last = (t == nt - 2);
            if constexpr (Epi::MIDK) { if (t == nt / 2) { if constexpr (F8) asm volatile("s_nop 15\n\ts_nop 15" ::: "memory"); E.midk(acc, ui, wr, fr, lds); } }
            const char* a1 = cA + (size_t)(t + 1) * kstep;
            const char* a2 = last ? nA : cA + (size_t)(t + 2) * kstep; const char* b2 = last ? nB : cB + (size_t)(t + 2) * kstep;
            const char* a3 = a2 + kstep; const char* b3 = b2 + kstep;
            unsigned av[2][2];
#pragma unroll
            for (int h = 0; h < 2; ++h)
#pragma unroll
                for (int i = 0; i < 2; ++i) av[h][i] = last ? nv[h][i] : cv[h][i];
            PG8_LDB(B0, 0, 0); PG8_LDB(B1, 0, 1); PG8_SCHED; PG8_LDA(At, 0, 0); PG8_STAGE_A(PG8_SA(1, 1), a1, 1, cv);
            PG8_WAIT_V(8); PG8_WAIT_L(0); PG8_BAR; PG8_MMA(0, 0, At, B0); PG8_MMA(0, 1, At, B1); PG8_BAR; PG8_SCHED;
            PG8_LDA(At, 0, 1); PG8_STAGE(PG8_SB(0, 0), b2, voffB); PG8_STAGE(PG8_SB(0, 1), b2 + hstep, voffB); PG8_STAGE_A(PG8_SA(0, 0), a2, 0, av);
            PG8_WAIT_V(8); PG8_WAIT_L(0); PG8_BAR; PG8_MMA(1, 0, At, B0); PG8_MMA(1, 1, At, B1); PG8_BAR; PG8_SCHED;
            PG8_LDB(B0, 1, 0); PG8_LDB(B1, 1, 1); PG8_SCHED; PG8_LDA(At, 1, 0); PG8_STAGE_A(PG8_SA(0, 1), a2, 1, av);
            PG8_WAIT_V(8); PG8_WAIT_L(0); PG8_BAR; PG8_MMA(0, 0, At, B0); PG8_MMA(0, 1, At, B1); PG8_BAR; PG8_SCHED;
            PG8_LDA(At, 1, 1); PG8_STAGE(PG8_SB(1, 0), b3, voffB); PG8_STAGE(PG8_SB(1, 1), b3 + hstep, voffB); PG8_STAGE_A(PG8_SA(1, 0), a3, 0, av);
            PG8_WAIT_V(8); PG8_WAIT_L(0); PG8_BAR; PG8_MMA(1, 0, At, B0); PG8_MMA(1, 1, At, B1); PG8_BAR; PG8_SCHED;
        }
        if constexpr (F8) asm volatile("s_nop 15\n\ts_nop 15\n\ts_nop 7" ::: "memory");
        if (wr == 0) PG8_BAR;
        for (int er = 0; er < (Epi::PROBE_REP ? EPI_REPS : 1); ++er) { if constexpr (Epi::MIDK) E.fin(acc, cur, ui, wr, wc, fr, fq, lds); else E(acc, cur, wr, wc, fr, fq); }
        if (!has_next) break;
#pragma unroll
        for (int a = 0; a < 2; ++a)
#pragma unroll
            for (int b = 0; b < 2; ++b)
#pragma unroll
                for (int m = 0; m < 4; ++m)
#pragma unroll
                    for (int n = 0; n < 2; ++n) acc[a][b][m][n] = (f32x4){0.f, 0.f, 0.f, 0.f};
        cur = nxt; cA = nA; cB = nB; ++ui;
#pragma unroll
        for (int h = 0; h < 2; ++h)
#pragma unroll
            for (int i = 0; i < 2; ++i) cv[h][i] = nv[h][i];
        if (wr == 1) PG8_BAR;
    }
    PG8_WAIT_V(0);
    PG8_BAR;
#undef PG8_SA
#undef PG8_SB
#undef PG8_STAGE
#undef PG8_STAGE_A
#undef PG8_LDA
#undef PG8_LDB
#undef PG8_MMA
#undef PG8_LD8
#undef PG8_WAIT_V
#undef PG8_WAIT_L
#undef PG8_BAR
#undef PG8_SCHED
#undef PG8_ROWS
}

struct EpiQKV {
    static constexpr bool PERM = true, PROBE_REP = false, MIDK = false;
    bf16* O; bf16* KVH;
    __device__ __forceinline__ void operator()(const f32x4 (&acc)[2][2][4][2], const Unit& u, int wr, int wc, int fr, int fq) const {
        const int row0 = u.pm * BM + wr * 64 + fr;
        const bool isq = (u.pn < 4 || (u.pn >= 6 && u.pn < 10));
        const size_t tb = (u.pn == 4) ? KVH_KA : (u.pn == 5) ? KVH_VA : (u.pn < 14) ? KVH_KB + (size_t)(u.pn - 10) * 4 * NT * 64 * 2 : KVH_VB + (size_t)(u.pn - 14) * 4 * NT * 64 * 2;
        bf16* P = isq ? O : (bf16*)((unsigned char*)KVH + tb);
        const int pitch = isq ? DIN : 64; const float sc = isq ? 0.125f * LOG2E : 1.0f;
        const int cin = wc * 32 + 8 * fq;
        size_t coff[2];
#pragma unroll
        for (int bj = 0; bj < 2; ++bj) { const int c = bj * HALF + cin; coff[bj] = isq ? (size_t)(u.pn * BM + c) : ((size_t)(c >> 6) * NT * 64 + (c & 63)); }
#pragma unroll
        for (int ai = 0; ai < 2; ++ai)
#pragma unroll
            for (int m = 0; m < 4; ++m) { bf16* rowp = P + (size_t)(row0 + ai * HALF + m * 16) * pitch;
#pragma unroll
                for (int bj = 0; bj < 2; ++bj) { const f32x4 v0 = acc[ai][bj][m][0] * sc, v1 = acc[ai][bj][m][1] * sc;
                    u32x4 w; w.x = cvtpk(v0[0], v0[1]); w.y = cvtpk(v0[2], v0[3]); w.z = cvtpk(v1[0], v1[1]); w.w = cvtpk(v1[2], v1[3]);
                    *(u32x4*)(rowp + coff[bj]) = w; } }
    }
};
struct EpiRes {
    static constexpr bool PERM = true, PROBE_REP = true, MIDK = true;
    const float* X; bf16* X1; const float* mod; const float* SSQ; float* RSS;
    static constexpr int TAB_OFF = 131072;
    __device__ __forceinline__ void midk(f32x4 (&acc)[2][2][4][2], int ui, int wr, int fr, LAS unsigned char* lds) const {
        const LAS float* tab = (const LAS float*)(lds + TAB_OFF) + (size_t)ui * 512;
#pragma unroll
        for (int ai = 0; ai < 2; ++ai)
#pragma unroll
            for (int m = 0; m < 4; ++m) { const float ratio = tab[2 * (ai * HALF + wr * 64 + m * 16 + fr)];
#pragma unroll
                for (int bj = 0; bj < 2; ++bj)
#pragma unroll
                    for (int n = 0; n < 2; ++n) acc[ai][bj][m][n] = acc[ai][bj][m][n] * ratio; }
    }
    __device__ __forceinline__ void fin(const f32x4 (&acc)[2][2][4][2], const Unit& u, int ui, int wr, int wc, int fr, int fq, LAS unsigned char* lds) const {
        const LAS float* tab = (const LAS float*)(lds + TAB_OFF) + (size_t)ui * 512;
        const int row0 = u.pm * BM + wr * 64 + fr, col0 = u.pn * BM + wc * 32 + 8 * fq;
        const float* gt = mod + (size_t)(u.pm >> 4) * 16384 + 4096;
        f32x4 gv[2][2];
#pragma unroll
        for (int bj = 0; bj < 2; ++bj)
#pragma unroll
            for (int n = 0; n < 2; ++n) gv[bj][n] = *(const f32x4*)(gt + col0 + bj * HALF + 4 * n);
#pragma unroll
        for (int ai = 0; ai < 2; ++ai)
#pragma unroll
            for (int m = 0; m < 4; ++m) { const int rl = ai * HALF + wr * 64 + m * 16 + fr; const size_t off = (size_t)(u.pm * BM + rl) * DM + col0;
                const float rB = tab[2 * rl + 1];
#pragma unroll
                for (int bj = 0; bj < 2; ++bj) { const f32x4 x0 = __builtin_nontemporal_load((const f32x4*)(X + off + bj * HALF)), x1 = __builtin_nontemporal_load((const f32x4*)(X + off + bj * HALF + 4));
                    const f32x4 v0 = x0 + gv[bj][0] * (acc[ai][bj][m][0] * rB), v1 = x1 + gv[bj][1] * (acc[ai][bj][m][1] * rB);
                    u32x4 w; w.x = cvtpk(v0[0], v0[1]); w.y = cvtpk(v0[2], v0[3]); w.z = cvtpk(v1[0], v1[1]); w.w = cvtpk(v1[2], v1[3]);
                    *(u32x4*)(X1 + off + bj * HALF) = w;
                    float p = (v0[0] * v0[0] + v0[1] * v0[1]) + (v0[2] * v0[2] + v0[3] * v0[3]) + (v1[0] * v1[0] + v1[1] * v1[1]) + (v1[2] * v1[2] + v1[3] * v1[3]);
                    p += __shfl_xor(p, 16); p += __shfl_xor(p, 32);
                    if (fq == 0) RSS[(size_t)(u.pm * BM + rl) * 64 + u.pn * 8 + wc * 2 + bj] = p; }
                asm volatile("" ::: "memory"); }
        (void)row0;
    }
    __device__ __forceinline__ void operator()(const f32x4 (&)[2][2][4][2], const Unit&, int, int, int, int) const {}
};
struct EpiGU {
    static constexpr bool PERM = true, PROBE_REP = false, MIDK = false;
    unsigned char* ACT;
    __device__ __forceinline__ void operator()(const f32x4 (&acc)[2][2][4][2], const Unit& u, int wr, int wc, int fr, int fq) const {
        const int row0 = u.pm * BM + wr * 64 + fr, col0 = u.pn * 128 + wc * 32 + 8 * fq; constexpr float us = 1.0f / (F8_SH * F8_SWGU);
#pragma unroll
        for (int ai = 0; ai < 2; ++ai)
#pragma unroll
            for (int m = 0; m < 4; ++m) { float r[8];
#pragma unroll
                for (int n = 0; n < 2; ++n)
#pragma unroll
                    for (int j = 0; j < 4; ++j) { const float g = acc[ai][0][m][n][j] * us, up = acc[ai][1][m][n][j] * us;
                        r[4 * n + j] = g * __builtin_amdgcn_rcpf(1.0f + __expf(-g)) * up * F8_SACT; }
                u32x2 w; w.x = cvt4_fp8(r[0], r[1], r[2], r[3]); w.y = cvt4_fp8(r[4], r[5], r[6], r[7]);
                *(u32x2*)(ACT + (size_t)(row0 + ai * HALF + m * 16) * DE + col0) = w; }
    }
};
struct EpiY {
    static constexpr bool PERM = true, PROBE_REP = false, MIDK = false;
    unsigned char* Y;
    __device__ __forceinline__ void operator()(const f32x4 (&acc)[2][2][4][2], const Unit& u, int wr, int wc, int fr, int fq) const {
        const int row0 = u.pm * BM + wr * 64 + fr, col0 = u.pn * BM + wc * 32 + 8 * fq;
#pragma unroll
        for (int ai = 0; ai < 2; ++ai)
#pragma unroll
            for (int m = 0; m < 4; ++m) { unsigned char* rowp = Y + (size_t)(row0 + ai * HALF + m * 16) * DM + col0;
#pragma unroll
                for (int bj = 0; bj < 2; ++bj) { constexpr float us = F8_SY / (F8_SACT * F8_SWD); const f32x4 v0 = acc[ai][bj][m][0] * us, v1 = acc[ai][bj][m][1] * us;
                    u32x2 w; w.x = cvt4_fp8(v0[0], v0[1], v0[2], v0[3]); w.y = cvt4_fp8(v1[0], v1[1], v1[2], v1[3]);
                    *(u32x2*)(rowp + bj * HALF) = w; } }
    }
};
}

struct Args { const float* in[22]; float* out; unsigned char* ws; int ph_lo, ph_hi; };
struct InPtrs {
    __device__ __forceinline__ const float* operator[](int k) const {
        const __attribute__((address_space(4))) char* p = (const __attribute__((address_space(4))) char*)__builtin_amdgcn_kernarg_segment_ptr();
        asm volatile("" : "+s"(p));
        return *(const float* const __attribute__((address_space(4)))*)(p + 8 * k);
    }
};
struct Ctx { InPtrs in; float* out; unsigned char* ws; };
static_assert(__builtin_offsetof(Args, in) == 0, "InPtrs reads Args::in at kernarg offset 0");
enum { I_X = 0, I_C, I_WADA, I_BADA, I_GMIX, I_WIN, I_SINKS, I_RELB, I_GOA, I_GOB, I_WOUT, I_GFFN, I_WRG, I_BRG, I_WRE, I_BRE, I_WGATE, I_WUP, I_WDOWN, I_WADAF, I_BADAF, I_GFIN };

__device__ __forceinline__ void p0_mod(const Ctx& a, LAS unsigned char* lds, int tid, int lane, int wave) {
    LAS float* cact = (LAS float*)lds;
    LAS float* red = (LAS float*)(lds + 32768);
    const float* c = a.in[I_C];
    for (int i = tid; i < 2048 * 4; i += 512) { const int b = i >> 11, k = i & 2047; const float v = c[i]; cact[k * 4 + b] = v / (1.0f + __expf(-v)); }
    __syncthreads();
    float* mod = (float*)(a.ws + WS_MOD);
    const int rsub = lane >> 4, cq = lane & 15;
    for (int cg = blockIdx.x; cg < 256; cg += gridDim.x) {
        const int col0 = cg * 64;
        const float* W; int ldw; const float* bias; int cc;
        if (col0 < 12288) { W = a.in[I_WADA]; ldw = 12288; bias = a.in[I_BADA]; cc = col0; } else { W = a.in[I_WADAF]; ldw = 4096; bias = a.in[I_BADAF]; cc = col0 - 12288; }
        float acc[4][4];
#pragma unroll
        for (int b = 0; b < 4; ++b)
#pragma unroll
            for (int j = 0; j < 4; ++j) acc[b][j] = 0.f;
        const float* wp = W + (size_t)(wave * 256 + rsub) * ldw + cc + 4 * cq;
#pragma unroll 8
        for (int i = 0; i < 64; ++i) {
            const f32x4 wv = __builtin_nontemporal_load((const f32x4*)(wp + (size_t)(4 * i) * ldw));
            const f32x4 ca = *(const LAS f32x4*)(cact + (wave * 256 + 4 * i + rsub) * 4);
#pragma unroll
            for (int b = 0; b < 4; ++b)
#pragma unroll
                for (int j = 0; j < 4; ++j) acc[b][j] += ca[b] * wv[j];
        }
#pragma unroll
        for (int b = 0; b < 4; ++b)
#pragma unroll
            for (int j = 0; j < 4; ++j) { float v = acc[b][j]; v += __shfl_xor(v, 16); v += __shfl_xor(v, 32); if (lane < 16) red[(wave * 4 + b) * 64 + 4 * cq + j] = v; }
        __syncthreads();
        if (tid < 256) { const int b = tid >> 6, col = tid & 63; float s = bias[cc + col];
#pragma unroll
            for (int w = 0; w < 8; ++w) s += red[(w * 4 + b) * 64 + col];
            mod[(size_t)b * 16384 + col0 + col] = s; }
        __syncthreads();
    }
}
template <bool NTS>
__device__ __forceinline__ void transpose_item(const float* W, int ldw, int k0, int n0, const float* kscale, bf16* dst, int Kd, LAS float* scr, int lane) {
    const int r = lane >> 4, q = lane & 15;
#pragma unroll 4
    for (int i = 0; i < 16; ++i) { const int kk = 4 * i + r; f32x4 v = __builtin_nontemporal_load((const f32x4*)(W + (size_t)(k0 + kk) * ldw + n0 + 4 * q));
        if (kscale) { const float s = kscale[k0 + kk]; v = v * s; }
        LAS float* sp = scr + kk * 65 + 4 * q; sp[0] = v[0]; sp[1] = v[1]; sp[2] = v[2]; sp[3] = v[3]; }
    LDS_WAIT();
    const int c = lane & 7;
#pragma unroll
    for (int j = 0; j < 8; ++j) { const int n = (lane >> 3) + 8 * j; const LAS float* s = scr + (8 * c) * 65 + n;
        u32x4 o; o.x = cvtpk(s[0 * 65], s[1 * 65]); o.y = cvtpk(s[2 * 65], s[3 * 65]); o.z = cvtpk(s[4 * 65], s[5 * 65]); o.w = cvtpk(s[6 * 65], s[7 * 65]);
        if (NTS) __builtin_nontemporal_store(o, (u32x4*)(dst + (size_t)n * Kd + 8 * c)); else *(u32x4*)(dst + (size_t)n * Kd + 8 * c) = o; }
    LDS_WAIT();
}
template <bool NTS>
__device__ __forceinline__ void transpose_item8(const float* W, int ldw, int k0, int n0, float scale, const float* kscale, unsigned char* dst8, int Kd, LAS float* scr, int lane) {
    const int r = lane >> 3, q = lane & 7;
    f32x4 v[16];
#pragma unroll
    for (int i = 0; i < 16; ++i) v[i] = __builtin_nontemporal_load((const f32x4*)(W + (size_t)(k0 + 8 * i + r) * ldw + n0 + 4 * q));
#pragma unroll
    for (int i = 0; i < 16; ++i) { if (kscale) v[i] = v[i] * kscale[k0 + 8 * i + r]; LAS float* sp = scr + (8 * i + r) * 33 + 4 * q; sp[0] = v[i][0]; sp[1] = v[i][1]; sp[2] = v[i][2]; sp[3] = v[i][3]; }
    LDS_WAIT();
    const int c = lane >> 3, nl = lane & 7;
#pragma unroll
    for (int j = 0; j < 4; ++j) { const int n = nl + 8 * j; const LAS float* sq = scr + (16 * c) * 33 + n; u32x4 o;
        o.x = cvt4_fp8(sq[0 * 33] * scale, sq[1 * 33] * scale, sq[2 * 33] * scale, sq[3 * 33] * scale); o.y = cvt4_fp8(sq[4 * 33] * scale, sq[5 * 33] * scale, sq[6 * 33] * scale, sq[7 * 33] * scale);
        o.z = cvt4_fp8(sq[8 * 33] * scale, sq[9 * 33] * scale, sq[10 * 33] * scale, sq[11 * 33] * scale); o.w = cvt4_fp8(sq[12 * 33] * scale, sq[13 * 33] * scale, sq[14 * 33] * scale, sq[15 * 33] * scale);
        if (NTS) __builtin_nontemporal_store(o, (u32x4*)(dst8 + (size_t)n * Kd + 16 * c)); else *(u32x4*)(dst8 + (size_t)n * Kd + 16 * c) = o; }
    LDS_WAIT();
}
constexpr int CV_IN = 32 * 72, CV_OUT = 32 * 32, CV_G = 32 * 256, CV_D = 32 * 256;
constexpr int CV_UP0 = CV_IN + CV_OUT + CV_G, CV_DN0 = CV_UP0 + CV_G, CV_ALL = CV_DN0 + CV_D;
constexpr int CV_G_P4 = CV_IN + CV_OUT + 20 * 256;
constexpr int CV_UP_TAIL = CV_UP0 + 10 * 256, CV_DN_TAIL = CV_DN0 + 0 * 256;
__device__ __forceinline__ void convert_items(const Ctx& a, LAS unsigned char* lds, int lane, int wave, int first, int last, int gw, int NGW) {
    LAS float* scr = (LAS float*)(lds + wave * 16896);
    bf16* WinT = (bf16*)(a.ws + WS_WIN); unsigned char* WoutT = a.ws + WS_WOUT; unsigned char* WguT = a.ws + WS_WGU; unsigned char* WdT = a.ws + WS_WD;
    for (int it = first + gw; it < last; it += NGW) {
        int r = it;
        if (r < CV_IN) { const int kb = r / 72, nb = r % 72; transpose_item<false>(a.in[I_WIN], DIN, 64 * kb, 64 * nb, nullptr, WinT + (size_t)(64 * nb) * DM + 64 * kb, DM, scr, lane); continue; } r -= CV_IN;
        if (r < CV_OUT) { const int kb = r >> 6, nb = r & 63; const float* ks = (kb < 8) ? a.in[I_GOA] : (a.in[I_GOB] - 1024);
            transpose_item8<true>(a.in[I_WOUT], DM, 128 * kb, 32 * nb, F8_SWO, ks, WoutT + (size_t)(32 * nb) * DM + 128 * kb, DM, scr, lane); continue; } r -= CV_OUT;
        if (r < 2 * CV_G) { const int up = r >= CV_G ? 1 : 0; if (up) r -= CV_G; const int e = r >> 8, rr = r & 255, kb = rr >> 4, nb = rr & 15, n0 = 32 * nb;
            const int drow = 256 * (n0 >> 7) + (n0 & 127) + 128 * up;
            transpose_item8<true>(a.in[up ? I_WUP : I_WGATE] + (size_t)e * DM * DE, DE, 128 * kb, n0, F8_SWGU, nullptr, WguT + ((size_t)e * 1024 + drow) * DM + 128 * kb, DM, scr, lane); continue; } r -= 2 * CV_G;
        { const int e = r >> 8, rr = r & 255, kb = rr >> 6, nb = rr & 63;
            transpose_item8<true>(a.in[I_WDOWN] + (size_t)e * DE * DM, DM, 128 * kb, 32 * nb, F8_SWD, nullptr, WdT + ((size_t)e * DM + 32 * nb) * DE + 128 * kb, DE, scr, lane); }
    }
}
__device__ __forceinline__ void p0_convert(const Ctx& a, LAS unsigned char* lds, int tid, int lane, int wave) {
    convert_items(a, lds, lane, wave, 0, CV_G_P4, blockIdx.x * 8 + wave, gridDim.x * 8);
    convert_items(a, lds, lane, wave, CV_UP0, CV_UP_TAIL, blockIdx.x * 8 + wave, gridDim.x * 8);
    convert_items(a, lds, lane, wave, CV_DN0, CV_DN_TAIL, blockIdx.x * 8 + wave, gridDim.x * 8);
    bf16* wrhi = (bf16*)(a.ws + WS_WRT); bf16* wrlo = wrhi + 48 * 2048;
    for (int i = blockIdx.x * 512 + tid; i < 48 * 2048; i += gridDim.x * 512) { const int col = i >> 11, k = i & 2047;
        const float v = col < 4 ? a.in[I_WRG][k * 4 + col] : (col < 36 ? a.in[I_WRE][k * 32 + col - 4] : 0.f);
        const unsigned h = cvtpk(v, 0.f); const float hf = bf_lo(h); const unsigned l = cvtpk(v - hf, 0.f);
        wrhi[i] = (bf16)(h & 0xffffu); wrlo[i] = (bf16)(l & 0xffffu); }
}

__device__ __forceinline__ void p1_norm(const Ctx& a, int lane, int wave) {
    const float* x = a.in[I_X]; const float* g = a.in[I_GMIX]; const float* mod = (const float*)(a.ws + WS_MOD); bf16* H = (bf16*)(a.ws + WS_H);
    const int gw = blockIdx.x * 8 + wave, NGW = gridDim.x * 8;
    { float* aux = (float*)(a.ws + WS_AUX);
      for (int i = gw; i < 4 * 36; i += NGW) { const int b = i / 36, c = i % 36; const float* sh = mod + (size_t)b * 16384 + 6144; float sacc = 0.f;
          for (int k = lane; k < DM; k += 64) sacc += sh[k] * (c < 4 ? a.in[I_WRG][k * 4 + c] : a.in[I_WRE][k * 32 + c - 4]);
          sacc = wave_sum(sacc); if (lane == 0) aux[b * 48 + c] = sacc + (c < 4 ? a.in[I_BRG][c] : a.in[I_BRE][c - 4]); }
      for (int i = blockIdx.x * 512 + threadIdx.x; i < 4 * DM; i += gridDim.x * 512) { const int b = i >> 11, k = i & 2047; aux[1024 + i] = a.in[I_GFFN][k] * (1.0f + mod[(size_t)b * 16384 + 8192 + k]); } }
    for (int grp = gw; grp < NT / 8; grp += NGW) {
        const int row0 = grp * 8, b = row0 >> 12;
        f32x4 A[8], Bv[8];
#pragma unroll
        for (int j = 0; j < 8; ++j) { const int k = 4 * lane + 256 * j; const f32x4 gg = *(const f32x4*)(g + k), sc = *(const f32x4*)(mod + (size_t)b * 16384 + 2048 + k);
            A[j] = gg * (1.0f + sc); Bv[j] = *(const f32x4*)(mod + (size_t)b * 16384 + k); }
        for (int r = 0; r < 8; ++r) {
            const float* xr = x + (size_t)(row0 + r) * DM + 4 * lane; f32x4 v[8]; float s = 0.f;
#pragma unroll
            for (int j = 0; j < 8; ++j) { v[j] = __builtin_nontemporal_load((const f32x4*)(xr + 256 * j)); s += (v[j][0] * v[j][0] + v[j][1] * v[j][1]) + (v[j][2] * v[j][2] + v[j][3] * v[j][3]); }
            const float rstd = __builtin_amdgcn_rsqf(wave_sum(s) * (1.0f / DM) + EPS);
            bf16* hr = H + (size_t)(row0 + r) * DM + 4 * lane;
#pragma unroll
            for (int j = 0; j < 8; ++j) { const f32x4 h = v[j] * rstd * A[j] + Bv[j]; u32x2 w; w.x = cvtpk(h[0], h[1]); w.y = cvtpk(h[2], h[3]); *(u32x2*)(hr + 256 * j) = w; }
        }
    }
}

__device__ __forceinline__ void att_glds16(unsigned voff, const void* sbase, unsigned lds_dst) { unsigned keep;
    asm volatile("s_mov_b32 %0, m0\n\ts_mov_b32 m0, %3\n\ts_nop 0\n\tglobal_load_lds_dwordx4 %1, %2\n\ts_mov_b32 m0, %0" : "=&s"(keep) : "v"(voff), "s"(sbase), "s"(lds_dst) : "memory"); }
__device__ __forceinline__ void att_dma_tile(const bf16* base, unsigned lds0, unsigned vo0, unsigned vo1) {
    unsigned keep;
#pragma unroll
    for (int h = 0; h < 2; ++h) {
        asm volatile("s_mov_b32 %0, m0\n\ts_mov_b32 m0, %4\n\ts_nop 0\n\t"
                     "global_load_lds_dwordx4 %1, %3\n\tglobal_load_lds_dwordx4 %2, %3 offset:1024\n\tglobal_load_lds_dwordx4 %1, %3 offset:2048\n\tglobal_load_lds_dwordx4 %2, %3 offset:3072\n\t"
                     "s_mov_b32 m0, %0" : "=&s"(keep) : "v"(vo0), "v"(vo1), "s"(base), "s"(lds0) : "memory");
        base += 4 * 8 * 64; lds0 += 4096u; asm volatile("" : "+s"(base), "+s"(lds0));
    }
}
#define ATT_DMAK(KB) att_dma_tile((KB), klu, kvo0, kvo0 ^ 64u)
#define ATT_DMAV(VB) att_dma_tile((VB), klu + 8192u, vvo, vvo)
__device__ __forceinline__ void att_scores(f32x16& s0, f32x16& s1, const bf16x8 (&qf)[4], const LAS unsigned char* kfp, int hh, int km, const LAS float* tbl,
                                           bool isA, int dd, float nslope2, float cb, int base0, float moff) {
    int bl = base0; asm volatile("" : "+v"(bl));
    const float fbl = (float)bl; float cadd = 0.f;
    if (isA) {
        if (dd > 0) { const float c00 = nslope2 * (fbl + 64.0f * (float)dd) - moff, c01 = c00 - 32.0f * nslope2;
#pragma unroll
            for (int r = 0; r < 16; ++r) { const float noff = -(float)((r & 3) + 8 * (r >> 2)); s0[r] = fmaf(nslope2, noff, c00); s1[r] = fmaf(nslope2, noff, c01); } }
        else { const float nm = -moff;
#pragma unroll
            for (int r = 0; r < 16; ++r) { const float off = (float)((r & 3) + 8 * (r >> 2)); s0[r] = fmaf(nslope2, fabsf(fbl - off), nm); s1[r] = fmaf(nslope2, fabsf(fbl - (off + 32.0f)), nm); } }
    } else if (dd >= 3) { cadd = cb - moff;
#pragma unroll
        for (int r = 0; r < 16; ++r) { s0[r] = 0.f; s1[r] = 0.f; }
    } else {
        const LAS float* p0 = tbl + (bl + 64 * dd + 64 - 27); const LAS float* p1 = p0 - 32;
#pragma unroll
        for (int r = 0; r < 16; ++r) { s0[r] = p0[27 - ((r & 3) + 8 * (r >> 2))] - moff; s1[r] = p1[27 - ((r & 3) + 8 * (r >> 2))] - moff; } }
    bf16x8 kf[8];
#pragma unroll
    for (int kt = 0; kt < 2; ++kt)
#pragma unroll
        for (int ks = 0; ks < 4; ++ks) kf[4 * kt + ks] = *(const LAS bf16x8*)(kfp + kt * 4096 + (((2 * ks + hh) ^ km) << 4));
#pragma unroll
    for (int ks = 0; ks < 4; ++ks) { s0 = __builtin_amdgcn_mfma_f32_32x32x16_bf16(kf[ks], qf[ks], s0, 0, 0, 0); s1 = __builtin_amdgcn_mfma_f32_32x32x16_bf16(kf[4 + ks], qf[ks], s1, 0, 0, 0); }
    if (!isA && dd >= 3) {
#pragma unroll
        for (int r = 0; r < 16; ++r) { s0[r] += cadd; s1[r] += cadd; } }
}
constexpr float ATT_THR = 4.0f;
template <bool FIRSTHALF>
__device__ __forceinline__ void att_softmax_pv(f32x16& s0, f32x16& s1, f32x16& o0, f32x16& o1, float& m2, float& l, const LAS unsigned char* vl, int tr0, bool first) {
    float mx = fmaxf(s0[0], s1[0]);
#pragma unroll
    for (int r = 1; r < 16; ++r) mx = fmaxf(fmaxf(mx, s0[r]), s1[r]);
    { const auto rr = __builtin_amdgcn_permlane32_swap(__float_as_uint(mx), __float_as_uint(mx), false, false); mx = fmaxf(__uint_as_float(rr[0]), __uint_as_float(rr[1])); }
    if (first || __any(mx > ATT_THR)) {
        float delta;
        if (first) { delta = mx; m2 = mx; }
        else { delta = fmaxf(mx, 0.f); m2 += delta; const float alpha = __builtin_amdgcn_exp2f(-delta); l *= alpha;
#pragma unroll
            for (int r = 0; r < 16; ++r) { float a0 = o0[r], a1 = o1[r]; asm volatile("v_mul_f32 %0, %2, %0\n\tv_mul_f32 %1, %2, %1" : "+v"(a0), "+v"(a1) : "v"(alpha)); o0[r] = a0; o1[r] = a1; } }
#pragma unroll
        for (int r = 0; r < 16; ++r) { float a0 = s0[r], a1 = s1[r]; asm volatile("v_sub_f32 %0, %0, %2\n\tv_sub_f32 %1, %1, %2" : "+v"(a0), "+v"(a1) : "v"(delta)); s0[r] = a0; s1[r] = a1; }
    }
    float rs = 0.f;
#pragma unroll
    for (int r = 0; r < 16; ++r) { s0[r] = __builtin_amdgcn_exp2f(s0[r]); s1[r] = __builtin_amdgcn_exp2f(s1[r]); rs += s0[r] + s1[r]; }
    l += rs;
    bf16x8 pb[2][2];
#pragma unroll
    for (int s = 0; s < 2; ++s) {
        u32x4 w0, w1;
        w0.x = cvtpk(s0[8 * s + 0], s0[8 * s + 1]); w0.y = cvtpk(s0[8 * s + 2], s0[8 * s + 3]); w0.z = cvtpk(s0[8 * s + 4], s0[8 * s + 5]); w0.w = cvtpk(s0[8 * s + 6], s0[8 * s + 7]);
        w1.x = cvtpk(s1[8 * s + 0], s1[8 * s + 1]); w1.y = cvtpk(s1[8 * s + 2], s1[8 * s + 3]); w1.z = cvtpk(s1[8 * s + 4], s1[8 * s + 5]); w1.w = cvtpk(s1[8 * s + 6], s1[8 * s + 7]);
        pb[0][s] = __builtin_bit_cast(bf16x8, w0); pb[1][s] = __builtin_bit_cast(bf16x8, w1); }
    if (FIRSTHALF) asm volatile("s_waitcnt vmcnt(0)" ::: "memory");
#pragma unroll
    for (int kt = 0; kt < 2; ++kt)
#pragma unroll
        for (int s = 0; s < 2; ++s)
#pragma unroll
            for (int dt = 0; dt < 2; ++dt) {
                const LAS unsigned char* ap = vl + (dt ? (tr0 ^ 64) : tr0) + (32 * kt + 16 * s) * 128;
                const s16x4 r1 = __builtin_bit_cast(s16x4, __builtin_amdgcn_ds_read_tr16_b64_v4i16((LAS s16x4*)ap));
                const s16x4 r2 = __builtin_bit_cast(s16x4, __builtin_amdgcn_ds_read_tr16_b64_v4i16((LAS s16x4*)(ap + 8 * 128)));
                const bf16x8 av = {r1[0], r1[1], r1[2], r1[3], r2[0], r2[1], r2[2], r2[3]};
                if (dt == 0) o0 = __builtin_amdgcn_mfma_f32_32x32x16_bf16(av, pb[kt][s], o0, 0, 0, 0);
                else o1 = __builtin_amdgcn_mfma_f32_32x32x16_bf16(av, pb[kt][s], o1, 0, 0, 0); }
}
__device__ __forceinline__ void p3_attn(const Ctx& a, LAS unsigned char* lds, int tid, int lane, int wave) {
    const bf16* qkv = (const bf16*)(a.ws + WS_QKV); unsigned char* O = a.ws + WS_O;
    const unsigned char* kvh = a.ws + WS_KVH;
    const float* sinks = a.in[I_SINKS]; const float* relb = a.in[I_RELB];
    LAS unsigned char* kl = lds + wave * 16384;
    LAS unsigned char* vl = kl + 8192;
    LAS float* tbl = (LAS float*)(lds + 131072 + wave * 1056);
    LAS float* ssqp = (LAS float*)(lds + 131072 + 8 * 1056);
    LAS float* rstd = (LAS float*)(lds + 131072 + 8 * 1056 + 8192);
    static_assert(131072 + 8 * 1056 + 8192 + 512 <= MISC_OFF, "attention LDS map");
    const int l31 = lane & 31, hh = lane >> 5;
    const int grp = lane >> 4, i16 = lane & 15;
    const int base0 = l31 - 4 * hh;
    const int vrow = lane >> 3, vch = lane & 7;
    const unsigned kvo0 = (unsigned)(vrow * 64 + 8 * (vch ^ ((lane >> 4) & 7))) * 2u, vvo = (unsigned)(vrow * 64 + 8 * (vch ^ (4 * ((lane >> 4) & 1)))) * 2u;
    const int km = (l31 >> 1) & 7, kro = l31 * 128;
    const int trrow = (4 * hh + (i16 >> 2)) * 128, trc0 = (2 * (grp & 1) + ((i16 & 3) >> 1)) ^ (4 * ((i16 >> 3) & 1));
    const int tr0 = trrow + trc0 * 16 + (i16 & 1) * 8;
    for (int u0 = blockIdx.x; u0 < 256; u0 += gridDim.x) {
        const int unit = (gridDim.x == 256) ? ((u0 & 7) * 32 + (u0 >> 3)) : u0;
        const int b = unit >> 6, ci = unit & 63, tok0 = b * SEQ + ci * 64;
        const int dmaxA = ci < 2 ? ci : 2, dmaxB = ci < 8 ? ci : 8;
        {
            const unsigned klu = (unsigned)(__UINTPTR_TYPE__)kl;
            const int kvn = wave >> 2, ktok0 = tok0;
            const bf16* kp = (const bf16*)(kvh + KVH_KA) + ((size_t)kvn * NT + ktok0) * 64; ATT_DMAK(kp);
            const bf16* vp = (const bf16*)(kvh + KVH_VA) + ((size_t)kvn * NT + ktok0) * 64; ATT_DMAV(vp);
        }
        bf16x8 qn0[4], qn1[4];
        { const bf16* qp = qkv + (size_t)(tok0 + l31) * DIN + COL_QA + wave * 64 + 8 * hh;
#pragma unroll
          for (int ks = 0; ks < 4; ++ks) { qn0[ks] = __builtin_nontemporal_load((const bf16x8*)(qp + 16 * ks)); qn1[ks] = __builtin_nontemporal_load((const bf16x8*)(qp + (size_t)32 * DIN + 16 * ks)); } }
        for (int it = 0; it < 4; ++it) {
            const int head = wave + 8 * it;
            const bool isA = it < 2;
            bf16x8 qf0[4], qf1[4];
            asm volatile("" :: "v"(qn0[0]), "v"(qn0[1]), "v"(qn0[2]), "v"(qn0[3]), "v"(qn1[0]), "v"(qn1[1]), "v"(qn1[2]), "v"(qn1[3]));
#pragma unroll
            for (int ks = 0; ks < 4; ++ks) { qf0[ks] = qn0[ks]; qf1[ks] = qn1[ks]; }
            const bf16 *kb0, *vb0; int dmax; float m2a, la, nslope2 = 0.f, cb = 0.f;
            if (isA) { const size_t ho = ((size_t)(head >> 2) * NT + tok0) * 64; kb0 = (const bf16*)(kvh + KVH_KA) + ho; vb0 = (const bf16*)(kvh + KVH_VA) + ho; dmax = dmaxA;
                m2a = sinks[head] * LOG2E; la = hh == 0 ? 1.0f : 0.f; nslope2 = -__builtin_amdgcn_exp2f(-0.5f * (float)(head + 1)) * LOG2E; }
            else { const int hb = head - 16; const size_t ho = ((size_t)hb * NT + tok0) * 64; kb0 = (const bf16*)(kvh + KVH_KB) + ho; vb0 = (const bf16*)(kvh + KVH_VB) + ho; dmax = dmaxB; m2a = -1e30f; la = 0.f;
                for (int i = lane; i < 256; i += 64) { const int rel = i - 64; tbl[i] = relb[hb * 257 + (rel > 128 ? 128 : rel) + 128] * LOG2E; }
                cb = relb[hb * 257 + 256] * LOG2E; }
            float m2b = m2a, lb = la;
            const int nhead = head + 8; const bool nA = (it + 1) < 2;
            const size_t nho = ((size_t)(nA ? (nhead >> 2) : (nhead - 16)) * NT + tok0) * 64;
            const bf16* nkb0 = (const bf16*)(kvh + (nA ? KVH_KA : KVH_KB)) + nho; const bf16* nvb0 = (const bf16*)(kvh + (nA ? KVH_VA : KVH_VB)) + nho;
            f32x16 oa0, oa1, ob0, ob1;
#pragma unroll
            for (int r = 0; r < 16; ++r) { oa0[r] = 0.f; oa1[r] = 0.f; ob0[r] = 0.f; ob1[r] = 0.f; }
            for (int dd = 0; dd <= dmax; ++dd) {
                const bool first = (!isA) && dd == 0;
                unsigned klu = (unsigned)(__UINTPTR_TYPE__)kl; asm volatile("" : "+s"(klu));
                asm volatile("s_waitcnt vmcnt(8)" ::: "memory");
                f32x16 s0, s1;
                att_scores(s0, s1, qf0, kl + kro, hh, km, tbl, isA, dd, nslope2, cb, base0, first ? 0.f : m2a);
                att_softmax_pv<true>(s0, s1, oa0, oa1, m2a, la, vl, tr0, first);
                att_scores(s0, s1, qf1, kl + kro, hh, km, tbl, isA, dd, nslope2, cb, base0 + 32, first ? 0.f : m2b);
                __builtin_amdgcn_sched_barrier(0);
                if (dd < dmax) { const bf16* kp = kb0 - (size_t)(64 * (dd + 1)) * 64; ATT_DMAK(kp); }
                else if (it < 3) { ATT_DMAK(nkb0); }
                att_softmax_pv<false>(s0, s1, ob0, ob1, m2b, lb, vl, tr0, first);
                __builtin_amdgcn_sched_barrier(0);
                if (dd < dmax) { const bf16* vp = vb0 - (size_t)(64 * (dd + 1)) * 64; ATT_DMAV(vp); }
                else if (it < 3) { ATT_DMAV(nvb0); }
            }
            if (it < 3) {
                const int nh = head + 8; const bf16* qp = qkv + (size_t)(tok0 + l31) * DIN + ((it + 1) < 2 ? COL_QA + nh * 64 : COL_QB + (nh - 16) * 64) + 8 * hh;
#pragma unroll
                for (int ks = 0; ks < 4; ++ks) { qn0[ks] = __builtin_nontemporal_load((const bf16x8*)(qp + 16 * ks)); qn1[ks] = __builtin_nontemporal_load((const bf16x8*)(qp + (size_t)32 * DIN + 16 * ks)); } }
#pragma unroll
            for (int qh = 0; qh < 2; ++qh) {
                f32x16& o0 = qh ? ob0 : oa0; f32x16& o1 = qh ? ob1 : oa1; float l = qh ? lb : la;
                { const auto rr = __builtin_amdgcn_permlane32_swap(__float_as_uint(l), __float_as_uint(l), false, false); l = __uint_as_float(rr[0]) + __uint_as_float(rr[1]); }
                const float inv = 1.0f / l; float ssq = 0.f;
#pragma unroll
                for (int r = 0; r < 16; ++r) { o0[r] *= inv; o1[r] *= inv; ssq += o0[r] * o0[r] + o1[r] * o1[r]; }
                ssq += __shfl_xor(ssq, 32);
                if (hh == 0) ssqp[head * 64 + 32 * qh + l31] = ssq;
                unsigned char* op = O + (size_t)(tok0 + 32 * qh + l31) * DM + head * 64 + 16 * hh;
#pragma unroll
                for (int dt = 0; dt < 2; ++dt) { const f32x16& ov = dt ? o1 : o0; unsigned d[4];
#pragma unroll
                    for (int r4 = 0; r4 < 4; ++r4) d[r4] = cvt4_fp8(ov[4 * r4] * F8_SO, ov[4 * r4 + 1] * F8_SO, ov[4 * r4 + 2] * F8_SO, ov[4 * r4 + 3] * F8_SO);
                    const auto s02 = __builtin_amdgcn_permlane32_swap(d[0], d[2], false, false), s13 = __builtin_amdgcn_permlane32_swap(d[1], d[3], false, false);
                    u32x4 w; w.x = s02[0]; w.y = s02[1]; w.z = s13[0]; w.w = s13[1];
                    *(u32x4*)(op + 32 * dt) = w; }
            }
        }
        __syncthreads();
        if (tid < 128) { const int g = tid >> 6, q = tid & 63; float sacc = 0.f;
#pragma unroll
            for (int h = 0; h < 16; ++h) sacc += ssqp[(16 * g + h) * 64 + q];
            float* SSQ = (float*)(a.ws + WS_SSQ); SSQ[(size_t)(tok0 + q) * 2 + g] = sacc; }
        __syncthreads();
    }
}

constexpr int P5_ROWB = 528;
__device__ __forceinline__ void p5_norm_router(const Ctx& a, LAS unsigned char* lds, int tid, int lane, int wave) {
    const bf16* x1 = (const bf16*)(a.ws + WS_X1); const float* mod = (const float*)(a.ws + WS_MOD); unsigned char* H = a.ws + WS_H;
    const float* aux = (const float*)(a.ws + WS_AUX);
    const bf16* wrhi = (const bf16*)(a.ws + WS_WRT); const bf16* wrlo = wrhi + 48 * 2048;
    unsigned char* rt = a.ws + WS_ROUTE;
    int* tok_e = (int*)(rt + RT_TOKE); float* tok_w = (float*)(rt + RT_TOKW); int* tok_rank = (int*)(rt + RT_RANK); int* cntWG = (int*)(rt + RT_CNT);
    constexpr int TILE_B = 16 * P5_ROWB, WR_B = 48 * P5_ROWB;
    const int pairi = wave >> 1, odd = wave & 1;
    LAS unsigned char* uh = lds + pairi * (2 * TILE_B);
    LAS unsigned char* ul = uh + TILE_B;
    LAS unsigned char* wh = lds + 4 * 2 * TILE_B;
    LAS unsigned char* wl = wh + WR_B;
    LAS float* up = (LAS float*)(lds + 4 * 2 * TILE_B + 2 * WR_B);
    LAS float* sp = up + 64 * 48;
    LAS float* lg = sp + 64;
    LAS float* rsd = lg + 64 * 48;
    static_assert(4 * 2 * TILE_B + 2 * WR_B + (64 * 48 + 64 + 64 * 48 + 64) * 4 <= MISC_OFF, "P5 LDS map");
    const int tr = lane & 15, kq = lane >> 4;
    const int hrow = lane >> 5, hl = lane & 31;
    for (int blk = blockIdx.x; blk < 256; blk += gridDim.x) {
        const int t0 = blk * 64 + pairi * 16, b = blk >> 6;
        const bf16* xw = x1 + (size_t)(t0 + 8 * odd + hrow) * DM + 8 * hl;
        const float* ap = aux + 1024 + b * DM + 8 * hl;
        const float* shp = mod + (size_t)b * 16384 + 6144 + 8 * hl; unsigned char* hwp = H + (size_t)(t0 + 8 * odd + hrow) * DM + 8 * hl;
        const int wrow0 = wave * 6;
        if (tid < 64) {
            const f32x4* pr = (const f32x4*)((const float*)(a.ws + WS_RSS) + (size_t)(blk * 64 + tid) * 64); f32x4 acc4 = pr[0];
#pragma unroll
            for (int i = 1; i < 16; ++i) acc4 = acc4 + pr[i];
            rsd[tid] = __builtin_amdgcn_rsqf(((acc4[0] + acc4[1]) + (acc4[2] + acc4[3])) * (1.0f / DM) + EPS); }
        __syncthreads();
        {
            f32x4 acc[2];
            acc[0] = (f32x4){0.f, 0.f, 0.f, 0.f}; acc[1] = (f32x4){0.f, 0.f, 0.f, 0.f};
            u32x4 xv[4], wv[6];
#pragma unroll
            for (int i = 0; i < 4; ++i) xv[i] = __builtin_nontemporal_load((const u32x4*)(xw + (size_t)(2 * i) * DM));
#pragma unroll
            for (int i = 0; i < 6; ++i) { const int r = 2 * (wrow0 + i) + hrow; wv[i] = *(const u32x4*)((r < 48 ? wrhi + (size_t)r * 2048 : wrlo + (size_t)(r - 48) * 2048) + 8 * hl); }
            for (int c4 = 0; c4 < 8; ++c4) {
                const f32x4 a0 = *(const f32x4*)(ap + 256 * c4), a1 = *(const f32x4*)(ap + 256 * c4 + 4), sh0 = *(const f32x4*)(shp + 256 * c4), sh1 = *(const f32x4*)(shp + 256 * c4 + 4);
                u32x4 xn[4];
                if (c4 < 7) {
#pragma unroll
                    for (int i = 0; i < 4; ++i) xn[i] = __builtin_nontemporal_load((const u32x4*)(xw + (size_t)(2 * i) * DM + 256 * (c4 + 1))); }
                __syncthreads();
#pragma unroll
                for (int i = 0; i < 4; ++i) { const u32x4 v = xv[i]; const int r = 8 * odd + 2 * i + hrow; const float rs = rsd[pairi * 16 + r];
                    const f32x4 f0 = {bf_lo(v.x), bf_hi(v.x), bf_lo(v.y), bf_hi(v.y)}, f1 = {bf_lo(v.z), bf_hi(v.z), bf_lo(v.w), bf_hi(v.w)};
                    const f32x4 u0 = f0 * a0, u1 = f1 * a1; u32x4 hi, lo;
                    { const f32x4 h0 = (u0 * rs + sh0) * F8_SH, h1 = (u1 * rs + sh1) * F8_SH; u32x2 hw; hw.x = cvt4_fp8(h0[0], h0[1], h0[2], h0[3]); hw.y = cvt4_fp8(h1[0], h1[1], h1[2], h1[3]);
                      *(u32x2*)(hwp + (size_t)(2 * i) * DM + 256 * c4) = hw; }
                    hi.x = cvtpk(u0[0], u0[1]); hi.y = cvtpk(u0[2], u0[3]); hi.z = cvtpk(u1[0], u1[1]); hi.w = cvtpk(u1[2], u1[3]);
                    lo.x = cvtpk(u0[0] - bf_lo(hi.x), u0[1] - bf_hi(hi.x)); lo.y = cvtpk(u0[2] - bf_lo(hi.y), u0[3] - bf_hi(hi.y));
                    lo.z = cvtpk(u1[0] - bf_lo(hi.z), u1[1] - bf_hi(hi.z)); lo.w = cvtpk(u1[2] - bf_lo(hi.w), u1[3] - bf_hi(hi.w));
                    *(LAS u32x4*)(uh + r * P5_ROWB + 16 * hl) = hi; *(LAS u32x4*)(ul + r * P5_ROWB + 16 * hl) = lo; }
#pragma unroll
                for (int i = 0; i < 6; ++i) { const int r = 2 * (wrow0 + i) + hrow; *(LAS u32x4*)(wh + r * P5_ROWB + 16 * hl) = wv[i]; }
                if (c4 < 7) {
#pragma unroll
                    for (int i = 0; i < 6; ++i) { const int r = 2 * (wrow0 + i) + hrow; wv[i] = *(const u32x4*)((r < 48 ? wrhi + (size_t)r * 2048 : wrlo + (size_t)(r - 48) * 2048) + 256 * (c4 + 1) + 8 * hl); } }
                __syncthreads();
#pragma unroll 2
                for (int kk = 0; kk < 8; ++kk) {
                    const bf16x8 ahi = *(const LAS bf16x8*)(uh + tr * P5_ROWB + 64 * kk + 16 * kq), alo = *(const LAS bf16x8*)(ul + tr * P5_ROWB + 64 * kk + 16 * kq);
                    if (!odd) {
#pragma unroll
                        for (int c = 0; c < 2; ++c) { const bf16x8 bhi = *(const LAS bf16x8*)(wh + (16 * c + tr) * P5_ROWB + 64 * kk + 16 * kq), blo = *(const LAS bf16x8*)(wl + (16 * c + tr) * P5_ROWB + 64 * kk + 16 * kq);
                            acc[c] = __builtin_amdgcn_mfma_f32_16x16x32_bf16(ahi, bhi, acc[c], 0, 0, 0);
                            acc[c] = __builtin_amdgcn_mfma_f32_16x16x32_bf16(ahi, blo, acc[c], 0, 0, 0);
                            acc[c] = __builtin_amdgcn_mfma_f32_16x16x32_bf16(alo, bhi, acc[c], 0, 0, 0); }
                    } else { const bf16x8 bhi = *(const LAS bf16x8*)(wh + (32 + tr) * P5_ROWB + 64 * kk + 16 * kq), blo = *(const LAS bf16x8*)(wl + (32 + tr) * P5_ROWB + 64 * kk + 16 * kq);
                        acc[0] = __builtin_amdgcn_mfma_f32_16x16x32_bf16(ahi, bhi, acc[0], 0, 0, 0);
                        acc[0] = __builtin_amdgcn_mfma_f32_16x16x32_bf16(ahi, blo, acc[0], 0, 0, 0);
                        acc[0] = __builtin_amdgcn_mfma_f32_16x16x32_bf16(alo, bhi, acc[0], 0, 0, 0); }
                }
                if (c4 < 7) {
#pragma unroll
                    for (int i = 0; i < 4; ++i) xv[i] = xn[i]; }
            }
            if (!odd) {
#pragma unroll
                for (int c = 0; c < 2; ++c)
#pragma unroll
                    for (int r = 0; r < 4; ++r) up[(pairi * 16 + 4 * kq + r) * 48 + 16 * c + tr] = acc[c][r];
            } else {
#pragma unroll
                for (int r = 0; r < 4; ++r) up[(pairi * 16 + 4 * kq + r) * 48 + 32 + tr] = acc[0][r];
            }
        }
        __syncthreads();
        for (int i = tid; i < 64 * 48; i += 512) { const int tok = i / 48, c = i - tok * 48; lg[i] = rsd[tok] * up[i] + aux[b * 48 + c]; }
        __syncthreads();
        if (tid < 64) {
            const int tt = blk * 64 + tid; const LAS float* L = lg + tid * 48;
            float gl[4]; int gi = 0;
#pragma unroll
            for (int j = 0; j < 4; ++j) gl[j] = L[j];
            float gm = gl[0];
#pragma unroll
            for (int j = 1; j < 4; ++j) if (gl[j] > gm) { gm = gl[j]; gi = j; }
            float den = 0.f;
#pragma unroll
            for (int j = 0; j < 4; ++j) den += __expf(gl[j] - gm);
            const float pg = 1.0f / den;
            float el[8];
#pragma unroll
            for (int i = 0; i < 8; ++i) el[i] = L[4 + 8 * gi + i];
            int i1 = 0; float v1 = el[0];
#pragma unroll
            for (int i = 1; i < 8; ++i) if (el[i] > v1) { v1 = el[i]; i1 = i; }
            int i2 = -1; float v2 = -3.0e38f;
#pragma unroll
            for (int i = 0; i < 8; ++i) if (i != i1 && el[i] > v2) { v2 = el[i]; i2 = i; }
            const float ex = __expf(v2 - v1), w1 = pg / (1.0f + ex), w2 = pg * ex / (1.0f + ex);
            const int e1 = gi * 8 + i1, e2 = gi * 8 + i2;
            const unsigned long long lt = (1ull << lane) - 1ull;
            int r1 = 0, r2 = 0, mycnt = 0;
            for (int e = 0; e < NEXP; ++e) { const unsigned long long m1 = __ballot(e1 == e), m2 = __ballot(e2 == e); const int c1 = __popcll(m1);
                if (e1 == e) r1 = __popcll(m1 & lt); if (e2 == e) r2 = c1 + __popcll(m2 & lt); if (lane == e) mycnt = c1 + __popcll(m2); }
            tok_e[2 * tt] = e1; tok_e[2 * tt + 1] = e2; tok_w[2 * tt] = w1; tok_w[2 * tt + 1] = w2; tok_rank[2 * tt] = r1; tok_rank[2 * tt + 1] = r2;
            if (lane < NEXP) cntWG[blk * NEXP + lane] = mycnt;
        }
        __syncthreads();
    }
}

__device__ __forceinline__ void p6_slots(const Ctx& a, LAS unsigned char* lds, int tid) {
    unsigned char* rt = a.ws + WS_ROUTE;
    const int* tok_e = (const int*)(rt + RT_TOKE); const int* tok_rank = (const int*)(rt + RT_RANK); int* tok_slot = (int*)(rt + RT_SLOT); const int* cntWG = (const int*)(rt + RT_CNT);
    int* rowidx = (int*)(rt + RT_ROWIDX); int* tile_exp = (int*)(rt + RT_TILEEXP); int* ntiles = (int*)(rt + RT_NTILES);
    LAS int* ptot = (LAS int*)lds;
    LAS int* ppre = ptot + 512;
    LAS int* tot = ppre + 512;
    LAS int* pre = tot + 32;
    LAS int* sb = pre + 32;
    for (int blk = blockIdx.x; blk < 256; blk += gridDim.x) {
        { const int e = tid & 31, part = tid >> 5; int st = 0, sp = 0;
            for (int w = part * 16; w < part * 16 + 16; ++w) { const int c = cntWG[w * NEXP + e]; st += c; if (w < blk) sp += c; }
            ptot[part * 32 + e] = st; ppre[part * 32 + e] = sp; }
        __syncthreads();
        if (tid < 32) { int st = 0, sp = 0;
#pragma unroll
            for (int p = 0; p < 16; ++p) { st += ptot[p * 32 + tid]; sp += ppre[p * 32 + tid]; }
            tot[tid] = st; pre[tid] = sp; }
        __syncthreads();
        if (tid == 0) { int s = 0; for (int e = 0; e < NEXP; ++e) { sb[e] = s; s += ((tot[e] + 255) >> 8) << 8; } sb[NEXP] = s; }
        __syncthreads();
        if (tid < 128) { const int tk = blk * 64 + (tid >> 1), j = tid & 1; const int e = tok_e[2 * tk + j]; const int slot = sb[e] + pre[e] + tok_rank[2 * tk + j];
            tok_slot[2 * tk + j] = slot; rowidx[slot] = tk; }
        if (blk < NEXP) { const int e = blk, s0 = sb[e] + tot[e], s1 = sb[e + 1];
            for (int s = s0 + tid; s < s1; s += 512) rowidx[s] = 0;
            for (int g = (sb[e] >> 8) + tid; g < (sb[e + 1] >> 8); g += 512) tile_exp[g] = e; }
        if (blk == 0 && tid == 0) ntiles[0] = sb[NEXP] >> 8;
        if (blk == 0 && tid <= NEXP) ((int*)(rt + RT_TSTART))[tid] = sb[tid] >> 8;
        __syncthreads();
    }
}

__device__ __forceinline__ void p9_final(const Ctx& a, int lane, int wave) {
    const bf16* X = (const bf16*)(a.ws + WS_X1); float* OUT = a.out; const float* gf = a.in[I_GFIN]; const float* mod = (const float*)(a.ws + WS_MOD); const unsigned char* Y = a.ws + WS_Y;
    unsigned char* rt = a.ws + WS_ROUTE; const int* tok_slot = (const int*)(rt + RT_SLOT); const float* tok_w = (const float*)(rt + RT_TOKW);
    const int gw = blockIdx.x * 8 + wave, NGW = gridDim.x * 8;
    for (int grp = gw; grp < NT / 8; grp += NGW) {
        const int row0 = grp * 8, b = row0 >> 12;
        f32x4 A[8], Bv[8], G2[8];
#pragma unroll
        for (int j = 0; j < 8; ++j) { const int k = 4 * lane + 256 * j; const f32x4 gg = *(const f32x4*)(gf + k), sc = *(const f32x4*)(mod + (size_t)b * 16384 + 12288 + 2048 + k);
            A[j] = gg * (1.0f + sc); Bv[j] = *(const f32x4*)(mod + (size_t)b * 16384 + 12288 + k); G2[j] = *(const f32x4*)(mod + (size_t)b * 16384 + 10240 + k); }
        const int lr = lane & 7; const int2 sl = *(const int2*)(tok_slot + 2 * (row0 + lr)); const f32x2_t wl = *(const f32x2_t*)(tok_w + 2 * (row0 + lr));
        for (int r = 0; r < 8; r += 2) {
            u32x2 xb[2][8]; unsigned ya[2][8], yb[2][8]; float w1[2], w2[2];
#pragma unroll
            for (int h = 0; h < 2; ++h) { const int t = row0 + r + h;
                const int s1 = __builtin_amdgcn_readlane(sl.x, r + h), s2 = __builtin_amdgcn_readlane(sl.y, r + h);
                w1[h] = __uint_as_float(__builtin_amdgcn_readlane(__float_as_uint(wl.x), r + h)) * (1.0f / F8_SY); w2[h] = __uint_as_float(__builtin_amdgcn_readlane(__float_as_uint(wl.y), r + h)) * (1.0f / F8_SY);
                const bf16* xr = X + (size_t)t * DM + 4 * lane; const unsigned char* y1 = Y + (size_t)s1 * DM + 4 * lane; const unsigned char* y2 = Y + (size_t)s2 * DM + 4 * lane;
#pragma unroll
                for (int j = 0; j < 8; ++j) { xb[h][j] = __builtin_nontemporal_load((const u32x2*)(xr + 256 * j)); ya[h][j] = __builtin_nontemporal_load((const unsigned*)(y1 + 256 * j)); yb[h][j] = __builtin_nontemporal_load((const unsigned*)(y2 + 256 * j)); } }
#pragma unroll
            for (int h = 0; h < 2; ++h) { float* outr = OUT + (size_t)(row0 + r + h) * DM + 4 * lane; f32x4 v[8]; float s = 0.f;
#pragma unroll
                for (int j = 0; j < 8; ++j) { const u32x2 x2 = xb[h][j]; const f32x4 xv = {bf_lo(x2.x), bf_hi(x2.x), bf_lo(x2.y), bf_hi(x2.y)};
                    const f32x2_t p0 = __builtin_amdgcn_cvt_pk_f32_fp8((int)ya[h][j], false), p1 = __builtin_amdgcn_cvt_pk_f32_fp8((int)ya[h][j], true), q0 = __builtin_amdgcn_cvt_pk_f32_fp8((int)yb[h][j], false), q1 = __builtin_amdgcn_cvt_pk_f32_fp8((int)yb[h][j], true);
                    f32x4 yv; yv[0] = w1[h] * p0[0] + w2[h] * q0[0]; yv[1] = w1[h] * p0[1] + w2[h] * q0[1]; yv[2] = w1[h] * p1[0] + w2[h] * q1[0]; yv[3] = w1[h] * p1[1] + w2[h] * q1[1];
                    v[j] = xv + G2[j] * yv; s += (v[j][0] * v[j][0] + v[j][1] * v[j][1]) + (v[j][2] * v[j][2] + v[j][3] * v[j][3]); }
                const float rstd = __builtin_amdgcn_rsqf(wave_sum(s) * (1.0f / DM) + EPS);
#pragma unroll
                for (int j = 0; j < 8; ++j) __builtin_nontemporal_store(v[j] * rstd * A[j] + Bv[j], (f32x4*)(outr + 256 * j)); }
        }
    }
}

constexpr int NPH = 10;
__global__ void __launch_bounds__(512, 2) hybrid_fwd(Args kargs) {
    extern __shared__ __attribute__((aligned(16))) unsigned char lds_raw[];
    LAS unsigned char* lds = (LAS unsigned char*)lds_raw;
    const int tid = threadIdx.x, lane = tid & 63, wave = __builtin_amdgcn_readfirstlane(tid >> 6);
    volatile LAS unsigned* MISC = (volatile LAS unsigned*)(lds + MISC_OFF);
    if (tid < 4) MISC[tid] = 0u;
    __syncthreads();
    const int lo = kargs.ph_lo, hi = kargs.ph_hi;
    Ctx args; args.out = kargs.out; args.ws = kargs.ws;
    XcdBarrier bar; bar.bar = (unsigned*)(args.ws + WS_CTL); bar.x = 0; bar.st = nullptr;
    if (hi - lo > 1) bar = xcd_barrier_post((unsigned*)(args.ws + WS_CTL), MISC);
#define IN(k) (lo <= (k) && (k) < hi)
#define REPS(k) (((REPEAT_MASK >> (k)) & 1) ? 2 : 1)
#define SEAM(k) do { if (IN(k) && IN((k) + 1)) xcd_barrier(bar); } while (0)

    if (IN(0)) for (int rep = 0; rep < REPS(0); ++rep) { p0_mod(args, lds, tid, lane, wave); p0_convert(args, lds, tid, lane, wave); __syncthreads(); }
    SEAM(0);
    if (IN(1)) for (int rep = 0; rep < REPS(1); ++rep) { p1_norm(args, lane, wave); }
    SEAM(1);
    if (IN(2)) for (int rep = 0; rep < REPS(2); ++rep) {
        pg8::DenseOrder S; S.init(args.ws + WS_H, args.ws + WS_WIN, NT, DIN, DM, (int)gridDim.x, (int)blockIdx.x);
        pg8::EpiQKV E{(bf16*)(args.ws + WS_QKV), (bf16*)(args.ws + WS_KVH)};
        { const int G = (int)gridDim.x, rem = S.nwg % G;
          if (rem != 0 && (int)blockIdx.x >= rem) convert_items(args, lds, lane, wave, CV_UP_TAIL, CV_DN0, ((int)blockIdx.x - rem) * 8 + wave, (G - rem) * 8);
          else if (rem == 0) convert_items(args, lds, lane, wave, CV_UP_TAIL, CV_DN0, (int)blockIdx.x * 8 + wave, G * 8);
          __syncthreads(); }
        pg8::gemm_phase<pg8::EpiQKV, pg8::DenseOrder, false>(lds, DM, S, E);
    }
    SEAM(2);
    if (IN(3)) for (int rep = 0; rep < REPS(3); ++rep) { p3_attn(args, lds, tid, lane, wave); }
    SEAM(3);
    if (IN(4)) for (int rep = 0; rep < REPS(4); ++rep) {
        pg8::DenseOrder S; S.init(args.ws + WS_O, args.ws + WS_WOUT, NT, DM, DM / 2, (int)gridDim.x, (int)blockIdx.x);
        pg8::EpiRes E{args.in[I_X], (bf16*)(args.ws + WS_X1), (const float*)(args.ws + WS_MOD), (const float*)(args.ws + WS_SSQ), (float*)(args.ws + WS_RSS)};
        { const int G = (int)gridDim.x; if ((int)blockIdx.x >= G / 2) convert_items(args, lds, lane, wave, CV_G_P4, CV_UP0, ((int)blockIdx.x - G / 2) * 8 + wave, (G - G / 2) * 8); __syncthreads(); }
        {
            LAS float* tab = (LAS float*)(lds + pg8::EpiRes::TAB_OFF); const float* SSQ = (const float*)(args.ws + WS_SSQ); pg8::Unit u;
            for (int i = 0; i < 8 && S.next(i, u); ++i)
                if (tid < 256) { const float qa = SSQ[(size_t)(u.pm * 256 + tid) * 2], qb = SSQ[(size_t)(u.pm * 256 + tid) * 2 + 1];
                    const float rA = __builtin_amdgcn_rsqf(qa * (1.0f / 1024.0f) + EPS), rB = __builtin_amdgcn_rsqf(qb * (1.0f / 1024.0f) + EPS);
                    tab[(i * 256 + tid) * 2] = rA / rB; tab[(i * 256 + tid) * 2 + 1] = rB * (1.0f / (F8_SO * F8_SWO)); }
            __syncthreads();
        }
        pg8::gemm_phase<pg8::EpiRes, pg8::DenseOrder, false, true>(lds, DM / 2, S, E);
    }
    SEAM(4);
    if (IN(5)) for (int rep = 0; rep < REPS(5); ++rep) { p5_norm_router(args, lds, tid, lane, wave); }
    SEAM(5);
    if (IN(6)) { p6_slots(args, lds, tid); }
    SEAM(6);
    if (IN(7)) for (int rep = 0; rep < REPS(7); ++rep) {
        unsigned char* rt = args.ws + WS_ROUTE;
        pg8::GroupedOrder S; S.A = (const char*)(args.ws + WS_H); S.Bt = (const char*)(args.ws + WS_WGU); S.estride = (size_t)1024 * DM; S.K = DM / 2;
        S.rowidx = (const int*)(rt + RT_ROWIDX);
        const int ntiles = *(const int*)(rt + RT_NTILES);
        pg8::EpiGU E{args.ws + WS_ACT};
        { const int G = (int)gridDim.x; const int* ts = (const int*)(rt + RT_TSTART);
          const int nlab = (G % 8 == 0) ? 8 : 1, Gx = G / nlab, myx = nlab == 8 ? ((int)blockIdx.x & 7) : 0, myj = nlab == 8 ? ((int)blockIdx.x >> 3) : (int)blockIdx.x;
          int numax = 0;
          for (int x = 0; x < nlab; ++x) { int nu = 0; for (int e = x; e < NEXP; e += nlab) nu += (ts[e + 1] - ts[e]) * 4; numax = nu > numax ? nu : numax; }
          const int maxc = (numax + Gx - 1) / Gx;
          int nconv = 0, myidx = -1;
          for (int x = 0; x < nlab; ++x) { int nu = 0; for (int e = x; e < NEXP; e += nlab) nu += (ts[e + 1] - ts[e]) * 4;
              int nfull = nu - Gx * (maxc - 1); nfull = nfull < 0 ? 0 : (nfull > Gx ? Gx : nfull);
              if (x == myx && myj >= nfull) myidx = nconv + (myj - nfull);
              nconv += Gx - nfull; }
          if (nconv == 0) convert_items(args, lds, lane, wave, CV_DN_TAIL, CV_ALL, (int)blockIdx.x * 8 + wave, G * 8);
          else if (myidx >= 0) convert_items(args, lds, lane, wave, CV_DN_TAIL, CV_ALL, myidx * 8 + wave, nconv * 8);
          __syncthreads(); }
        S.build(lds, (const int*)(rt + RT_TSTART), 4, (int)gridDim.x, (int)blockIdx.x);
        pg8::gemm_phase<pg8::EpiGU, pg8::GroupedOrder, true, true>(lds, DM / 2, S, E);
    }
    SEAM(7);
    if (IN(8)) for (int rep = 0; rep < REPS(8); ++rep) {
        unsigned char* rt = args.ws + WS_ROUTE;
        pg8::GroupedOrder S; S.A = (const char*)(args.ws + WS_ACT); S.Bt = (const char*)(args.ws + WS_WD); S.estride = (size_t)DM * DE; S.K = DE / 2;
        S.rowidx = nullptr; S.build(lds, (const int*)(rt + RT_TSTART), 8, (int)gridDim.x, (int)blockIdx.x);
        pg8::EpiY E{args.ws + WS_Y};
        pg8::gemm_phase<pg8::EpiY, pg8::GroupedOrder, false, true>(lds, DE / 2, S, E);
    }
    SEAM(8);
    if (IN(9)) { p9_final(args, lane, wave); }
#undef IN
#undef SEAM
}

extern "C" void kernel_launch(void* const* d_in, const int* in_sizes, int n_in, void* d_out, int out_size, void* d_ws, size_t ws_size, hipStream_t stream) {
    static int grid = 0;
    if (grid == 0) {
        if (n_in != 22 || out_size != NT * DM || ws_size < WS_END) { fprintf(stderr, "kernel_launch: unexpected shapes (n_in %d, out %d, ws %zu)\n", n_in, out_size, ws_size); grid = -1; return; }
        int dev = 0, cus = 0, per_cu = 0;
        if (hipGetDevice(&dev) != hipSuccess || hipDeviceGetAttribute(&cus, hipDeviceAttributeMultiprocessorCount, dev) != hipSuccess) { grid = -1; return; }
        if (hipFuncSetAttribute((const void*)hybrid_fwd, hipFuncAttributeMaxDynamicSharedMemorySize, LDS_BYTES) != hipSuccess) { fprintf(stderr, "kernel_launch: hipFuncSetAttribute failed\n"); grid = -1; return; }
        if (hipOccupancyMaxActiveBlocksPerMultiprocessor(&per_cu, (const void*)hybrid_fwd, 512, LDS_BYTES) != hipSuccess || per_cu < 1) { fprintf(stderr, "kernel_launch: occupancy query says %d\n", per_cu); }
        (void)hipGetLastError();
        grid = cus;
    }
    if (grid < 0) return;
    (void)hipMemsetAsync((char*)d_ws + WS_CTL, 0, CTL_ZERO_BYTES, stream);
    Args a{};
    for (int i = 0; i < 22; ++i) a.in[i] = (const float*)d_in[i];
    a.out = (float*)d_out; a.ws = (unsigned char*)d_ws;
#if MK_PER_PHASE
    for (int p = 0; p < NPH; ++p) { a.ph_lo = p; a.ph_hi = p + 1; hipLaunchKernelGGL(hybrid_fwd, dim3(grid), dim3(512), LDS_BYTES, stream, a); }
#else
    if (PROBE_EXTRA_PHASE >= 0) {
        a.ph_lo = 0; a.ph_hi = PROBE_EXTRA_PHASE + 1; hipLaunchKernelGGL(hybrid_fwd, dim3(grid), dim3(512), LDS_BYTES, stream, a);
        (void)hipMemsetAsync((char*)d_ws + WS_CTL, 0, CTL_ZERO_BYTES, stream);
        a.ph_lo = PROBE_EXTRA_PHASE; a.ph_hi = PROBE_EXTRA_PHASE + 1; hipLaunchKernelGGL(hybrid_fwd, dim3(grid), dim3(512), LDS_BYTES, stream, a);
        if (PROBE_EXTRA_PHASE + 1 < NPH) { a.ph_lo = PROBE_EXTRA_PHASE + 1; a.ph_hi = NPH; hipLaunchKernelGGL(hybrid_fwd, dim3(grid), dim3(512), LDS_BYTES, stream, a); }
    } else { a.ph_lo = 0; a.ph_hi = NPH; hipLaunchKernelGGL(hybrid_fwd, dim3(grid), dim3(512), LDS_BYTES, stream, a); }
#endif
}
```

```cpp
#include <hip/hip_runtime.h>
#include <cstdio>
#include <cstdint>

#ifndef MK_PER_PHASE
#define MK_PER_PHASE 0
#endif

#ifndef PROBE_EXTRA_PHASE
#define PROBE_EXTRA_PHASE -1
#endif
#ifndef EPI_REPS
#define EPI_REPS 1
#endif
#ifndef REPEAT_MASK
#define REPEAT_MASK 0
#endif
#define GAS __attribute__((address_space(1)))
#define LAS __attribute__((address_space(3)))
typedef unsigned short bf16;
typedef short bf16x8 __attribute__((ext_vector_type(8)));
typedef short s16x4 __attribute__((ext_vector_type(4)));
typedef float f32x4 __attribute__((ext_vector_type(4)));
typedef float f32x16 __attribute__((ext_vector_type(16)));
typedef unsigned u32x4 __attribute__((ext_vector_type(4)));
typedef unsigned u32x2 __attribute__((ext_vector_type(2)));
typedef float f32x2_t __attribute__((ext_vector_type(2)));
typedef __bf16 bf16x2_t __attribute__((ext_vector_type(2)));

constexpr int DM = 2048, NB = 4, SEQ = 4096, NT = NB * SEQ, DIN = 4608, NEXP = 32, DE = 512;
constexpr int COL_QA = 0, COL_KA = 1024, COL_VA = 1280, COL_QB = 1536, COL_KB = 2560, COL_VB = 3584;
constexpr int MAXTILES = 160, MAXSLOTS = MAXTILES * 256;
constexpr float EPS = 1e-6f, LOG2E = 1.4426950408889634f;

constexpr size_t MiB = 1u << 20;
constexpr size_t WS_CTL = 0, CTL_ZERO_BYTES = 16384;
constexpr size_t WS_MOD = 1 * MiB;
constexpr size_t WS_ROUTE = 2 * MiB;
constexpr size_t RT_TOKE = 0, RT_TOKW = 131072, RT_RANK = 262144, RT_SLOT = 393216, RT_CNT = 524288, RT_ROWIDX = 557056, RT_TILEEXP = 720896, RT_NTILES = 724992, RT_TSTART = 729088;
constexpr size_t WS_AUX = 3 * MiB;
constexpr size_t WS_SSQ = 3 * MiB + 512 * 1024;
constexpr size_t WS_WRT = 4 * MiB;
constexpr size_t WS_WIN = 5 * MiB;
constexpr size_t WS_WOUT = 23 * MiB;
constexpr size_t WS_WGU = 32 * MiB;
constexpr size_t WS_WD = 160 * MiB;
constexpr size_t WS_H = 224 * MiB;
constexpr size_t WS_QKV = 288 * MiB;
constexpr size_t WS_O = 432 * MiB;
constexpr size_t WS_Y = 288 * MiB;
constexpr size_t WS_ACT = 448 * MiB;
constexpr size_t WS_X1 = 496 * MiB;
constexpr size_t WS_KVH = 560 * MiB;
constexpr int MOD_CTR = 3600;
constexpr size_t KVH_KA = 0, KVH_VA = 8 * MiB, KVH_KB = 16 * MiB, KVH_VB = 48 * MiB;
constexpr size_t WS_RSS = 640 * MiB;
constexpr size_t WS_END = 644 * MiB;

constexpr int RING_BYTES = 131072;
constexpr int MISC_OFF = 151552;
constexpr int LDS_BYTES = 155648;

__device__ __forceinline__ unsigned cvtpk(float lo, float hi) { f32x2_t v = {lo, hi}; bf16x2_t b = __builtin_convertvector(v, bf16x2_t); return __builtin_bit_cast(unsigned, b); }
__device__ __forceinline__ unsigned cvt4_fp8(float a, float b, float c, float d) {
    a = __builtin_fminf(__builtin_fmaxf(a, -448.f), 448.f); b = __builtin_fminf(__builtin_fmaxf(b, -448.f), 448.f);
    c = __builtin_fminf(__builtin_fmaxf(c, -448.f), 448.f); d = __builtin_fminf(__builtin_fmaxf(d, -448.f), 448.f);
    int r = 0; r = __builtin_amdgcn_cvt_pk_fp8_f32(a, b, r, false); r = __builtin_amdgcn_cvt_pk_fp8_f32(c, d, r, true); return (unsigned)r; }
constexpr float F8_SH = 8.0f, F8_SWGU = 1024.0f, F8_SACT = 8.0f, F8_SWD = 512.0f, F8_SY = 32.0f, F8_SO = 64.0f, F8_SWO = 1024.0f;
__device__ __forceinline__ float bf_lo(unsigned u) { return __uint_as_float(u << 16); }
__device__ __forceinline__ float bf_hi(unsigned u) { return __uint_as_float(u & 0xffff0000u); }
__device__ __forceinline__ float wave_sum(float v) {
#pragma unroll
    for (int o = 1; o < 64; o <<= 1) v += __shfl_xor(v, o);
    return v;
}
#define LDS_WAIT() asm volatile("s_waitcnt lgkmcnt(0)" ::: "memory")

#define XB_TMO      128
#define XB_XCNT(j)  (256  + 64 * (j))
#define XB_XSUB(j)  (1280 + 64 * (j))
#define XB_XGEN(j)  (2304 + 64 * (j))
#define XB_TOP      3328
#define XB_TOPGEN   3392
#define XCD_BAR_WORDS 3456
#define XB_SPIN_CAP (1u << 18)

__device__ __forceinline__ unsigned xb_ld(unsigned* p)              { return __hip_atomic_load(p, __ATOMIC_RELAXED, __HIP_MEMORY_SCOPE_AGENT); }
__device__ __forceinline__ unsigned xb_add(unsigned* p, unsigned v) { return __hip_atomic_fetch_add(p, v, __ATOMIC_RELAXED, __HIP_MEMORY_SCOPE_AGENT); }
__device__ __forceinline__ unsigned xb_xcc_id() { return (unsigned)__builtin_amdgcn_s_getreg((3 << 11) | 20) & 0xFu; }
#define XB_SPIN(cond, bar) do { unsigned _sp = 0; while (cond) { __builtin_amdgcn_s_sleep(1); \
    if ((++_sp & 255u) == 0u) { if (xb_ld(&(bar)[XB_TMO])) break; if (_sp > XB_SPIN_CAP) { atomicAdd(&(bar)[XB_TMO], 1u); break; } } } } while (0)

struct XcdBarrier { unsigned* bar; unsigned x; volatile LAS unsigned* st; };

__device__ __forceinline__ XcdBarrier xcd_barrier_post(unsigned* bar, volatile LAS unsigned* st) {
    XcdBarrier b; b.bar = bar; b.x = xb_xcc_id(); b.st = st;
    if (threadIdx.x == 0) (void)xb_add(&bar[XB_XCNT(b.x)], 1u);
    return b;
}
__device__ __forceinline__ void xcd_barrier_complete(unsigned* bar, unsigned x, unsigned& nloc, unsigned& nx) {
    const unsigned G = gridDim.x * gridDim.y * gridDim.z;
    unsigned sum, cnt, mine, sp = 0u;
    for (;;) {
        sum = 0u; cnt = 0u; mine = 0u;
#pragma unroll
        for (unsigned j = 0; j < 16; ++j) { const unsigned c = xb_ld(&bar[XB_XCNT(j)]); sum += c; cnt += (c > 0u) ? 1u : 0u; mine = (j == x) ? c : mine; }
        if (sum == G) break;
        __builtin_amdgcn_s_sleep(1);
        if ((++sp & 255u) == 0u) { if (xb_ld(&bar[XB_TMO])) break; if (sp > XB_SPIN_CAP) { atomicAdd(&bar[XB_TMO], 1u); break; } }
    }
    nloc = mine > 0u ? mine : 1u; nx = cnt > 0u ? cnt : 1u;
}
__device__ __forceinline__ void xcd_barrier(const XcdBarrier& b) {
    asm volatile("s_waitcnt vmcnt(0)" ::: "memory");
    __syncthreads();
    if (threadIdx.x == 0) {
        unsigned* bar = b.bar;
        __builtin_amdgcn_s_waitcnt(0);
        unsigned nloc = b.st[0], nx = b.st[1];
        if (nloc == 0u) { xcd_barrier_complete(bar, b.x, nloc, nx); b.st[0] = nloc; b.st[1] = nx; }
        const unsigned old = xb_add(&bar[XB_XSUB(b.x)], 1u);
        const unsigned gen = old / nloc;
        if (old + 1u == (gen + 1u) * nloc) {
            __builtin_amdgcn_fence(__ATOMIC_RELEASE, "agent");
            asm volatile("s_waitcnt vmcnt(0)" ::: "memory");
            const unsigned og = xb_add(&bar[XB_TOP], 1u);
            const unsigned tg = og / nx;
            if (og + 1u == (tg + 1u) * nx) xb_add(&bar[XB_TOPGEN], 1u);
            else XB_SPIN(xb_ld(&bar[XB_TOPGEN]) == tg, bar);
            __builtin_amdgcn_fence(__ATOMIC_ACQUIRE, "agent");
            xb_add(&bar[XB_XGEN(b.x)], 1u);
            asm volatile("s_waitcnt vmcnt(0)" ::: "memory");
        } else {
            XB_SPIN(xb_ld(&bar[XB_XGEN(b.x)]) == gen, bar);
            __builtin_amdgcn_fence(__ATOMIC_ACQUIRE, "agent");
            asm volatile("s_waitcnt vmcnt(0)" ::: "memory");
        }
    }
    __syncthreads();
}

struct XcdTicket { unsigned gen; int leader; };
__device__ __forceinline__ XcdTicket xcd_barrier_arrive(const XcdBarrier& b) {
    XcdTicket t; t.gen = 0u; t.leader = 0;
    asm volatile("s_waitcnt vmcnt(0)" ::: "memory");
    __syncthreads();
    if (threadIdx.x == 0) {
        unsigned* bar = b.bar;
        __builtin_amdgcn_s_waitcnt(0);
        unsigned nloc = b.st[0], nx = b.st[1];
        if (nloc == 0u) { xcd_barrier_complete(bar, b.x, nloc, nx); b.st[0] = nloc; b.st[1] = nx; }
        const unsigned old = xb_add(&bar[XB_XSUB(b.x)], 1u);
        const unsigned gen = old / nloc; t.gen = gen;
        if (old + 1u == (gen + 1u) * nloc) { t.leader = 1;
            __builtin_amdgcn_fence(__ATOMIC_RELEASE, "agent");
            asm volatile("s_waitcnt vmcnt(0)" ::: "memory");
            const unsigned og = xb_add(&bar[XB_TOP], 1u);
            const unsigned tg = og / nx;
            if (og + 1u == (tg + 1u) * nx) xb_add(&bar[XB_TOPGEN], 1u);
            else XB_SPIN(xb_ld(&bar[XB_TOPGEN]) == tg, bar);
            __builtin_amdgcn_fence(__ATOMIC_ACQUIRE, "agent");
            xb_add(&bar[XB_XGEN(b.x)], 1u);
            asm volatile("s_waitcnt vmcnt(0)" ::: "memory");
        }
    }
    return t;
}
__device__ __forceinline__ void xcd_barrier_wait(const XcdBarrier& b, const XcdTicket& t) {
    if (threadIdx.x == 0 && !t.leader) {
        unsigned* bar = b.bar;
        XB_SPIN(xb_ld(&bar[XB_XGEN(b.x)]) == t.gen, bar);
        __builtin_amdgcn_fence(__ATOMIC_ACQUIRE, "agent");
        asm volatile("s_waitcnt vmcnt(0)" ::: "memory");
    }
    __syncthreads();
}

namespace pg8 {
constexpr int BM = 256, BK = 64, HALF = 128, HTB = HALF * BK * 2, STAGE_BYTES = 8 * HTB, NXCD = 8, WGM = 8;
__host__ __device__ __forceinline__ int lds_byte(int r, int c) { const int st = (r >> 4) * 2 + (c >> 5), rr = r & 15, cc = c & 31, ob = rr * 64 + cc * 2; return st * 1024 + (ob ^ (((ob >> 9) & 1) << 5)); }
__host__ __device__ __forceinline__ void stage_rc(int b, int& R, int& C) { const int st = b / 1024, sb = b % 1024, swz = sb ^ (((sb >> 9) & 1) << 5); R = (st >> 1) * 16 + swz / 64; C = (st & 1) * 32 + (swz % 64) / 2; }
__host__ __device__ __forceinline__ int perm32(int rho) { const int n = rho >> 4, i = rho & 15; return 8 * (i >> 2) + 4 * n + (i & 3); }

struct Unit { int pm, pn, e, r0, h; };

struct DenseOrder {
    const char* A; const char* Bt; int K; int nM, nN, nwg, G, c;
    __device__ __forceinline__ void init(const void* A_, const void* Bt_, int M, int N, int K_, int G_, int c_) { A = (const char*)A_; Bt = (const char*)Bt_; K = K_; nM = M / BM; nN = N / BM; nwg = nM * nN; G = G_; c = c_; }
    __device__ __forceinline__ bool next(int i, Unit& u) const {
        const long L = (long)i * G + c; if (L >= nwg) return false;
        int wgid = (int)L; { const int q = nwg / NXCD, r = nwg % NXCD, xcd = wgid % NXCD, off = wgid / NXCD; wgid = (xcd < r ? xcd * (q + 1) : r * (q + 1) + (xcd - r) * q) + off; }
        const int nig = WGM * nN, gid = wgid / nig, fm = gid * WGM, gsz = (nM - fm) < WGM ? (nM - fm) : WGM;
        u.pm = fm + ((wgid % nig) % gsz); u.pn = (wgid % nig) / gsz; u.e = 0; u.r0 = u.pm * BM; u.h = 0; return true;
    }
    __device__ __forceinline__ const char* a_ptr(const Unit& u) const { return A + (size_t)u.pm * ((size_t)BM * K * 2); }
    __device__ __forceinline__ const char* b_ptr(const Unit& u) const { return Bt + (size_t)u.pn * ((size_t)BM * K * 2); }
    __device__ __forceinline__ const int* rows(const Unit&) const { return nullptr; }
};
struct GroupedOrder {
    const char* A; const char* Bt; size_t estride; int K; const int* rowidx; const LAS int* ulist;
    static constexpr int GO_MAXU = 48, LIST_OFF = 131072;
    __device__ __forceinline__ static void label_shape(const int* tstart, int nN, int x, int nlab, int Gx, int& nu, int& fullr, int& R, int& split) {
        nu = 0; for (int e = x; e < NEXP; e += nlab) nu += (tstart[e + 1] - tstart[e]) * nN;
        fullr = nu / Gx; R = nu - fullr * Gx; split = (R > 0 && 2 * R <= Gx) ? 1 : 0;
    }
    __device__ __forceinline__ void build(LAS unsigned char* lds, const int* tstart, int nN, int G, int c) {
        LAS int* L = (LAS int*)(lds + LIST_OFF); ulist = L;
        if (threadIdx.x < GO_MAXU) {
            const int i = threadIdx.x; int Gx, x, j, nlab;
            if (G % 8 == 0) { Gx = G >> 3; x = c & 7; j = c >> 3; nlab = 8; } else { Gx = G; x = 0; j = c; nlab = 1; }
            int nu, fullr, R, split; label_shape(tstart, nN, x, nlab, Gx, nu, fullr, R, split);
            int q = -1, part = 0, half = 0;
            if (i < fullr) q = j + Gx * i;
            else if (i == fullr) { if (split) { if (j < 2 * R) { q = fullr * Gx + (j >> 1); part = j & 1; half = 1; } } else if (j < R) q = j + Gx * i; }
            int pm = 0, ee = 0, ok = 0, pn = 0;
            if (q >= 0) { int tq = q / nN; pn = q - tq * nN;
                for (int e = x; e < NEXP; e += nlab) { const int s0 = tstart[e], cnt = tstart[e + 1] - s0; if (tq < cnt) { pm = s0 + tq; ee = e; ok = 1; break; } tq -= cnt; } }
            L[4 * i] = pm * BM + 128 * part; L[4 * i + 1] = pn; L[4 * i + 2] = ee; L[4 * i + 3] = ok | (half << 1);
        }
        __syncthreads();
    }
    __device__ __forceinline__ bool next(int i, Unit& u) const {
        if (i >= GO_MAXU) return false;
        const LAS int* p = ulist + 4 * i; u.r0 = p[0]; u.pm = u.r0 >> 8; u.pn = p[1]; u.e = p[2]; const int f = __builtin_amdgcn_readfirstlane(p[3]); u.h = (f >> 1) & 1; return (f & 1) != 0;
    }
    __device__ __forceinline__ const char* a_ptr(const Unit& u) const { return rowidx ? A : A + (size_t)u.r0 * ((size_t)K * 2); }
    __device__ __forceinline__ const char* b_ptr(const Unit& u) const { return Bt + (size_t)u.e * estride + (size_t)u.pn * ((size_t)BM * K * 2); }
    __device__ __forceinline__ const int* rows(const Unit& u) const { return rowidx + u.r0; }
};

typedef int v4i_t __attribute__((ext_vector_type(4)));
typedef int v8i_t __attribute__((ext_vector_type(8)));
template <class Epi, class Sched, bool GATHER, bool F8 = false>
__device__ __forceinline__ void gemm_phase(LAS unsigned char* lds, const int K, const Sched& S, const Epi& E) {
    const int tid = threadIdx.x, wid = __builtin_amdgcn_readfirstlane(tid >> 6), lane = tid & 63, wr = wid >> 2, wc = wid & 3, fr = lane & 15, fq = lane >> 4;
    const int nt = K / BK;
    unsigned voffA[2], voffB[2], rA[2], cA2[2];
#pragma unroll
    for (int i = 0; i < 2; ++i) { int R, C; stage_rc(tid * 16 + i * 8192, R, C); const int Rb = Epi::PERM ? ((R & ~31) + perm32(R & 31)) : R;
        voffA[i] = (unsigned)(R * K + C) * 2u; voffB[i] = (unsigned)(Rb * K + C) * 2u; rA[i] = (unsigned)R; cA2[i] = (unsigned)C * 2u; }
    const size_t kstep = (size_t)(BK * 2);
    const size_t hstep = (size_t)HALF * K * 2;
    const unsigned ldsw = (unsigned)wid * 1024u;
    const int aoff = lds_byte(wr * 64 + fr, fq * 8), boff = lds_byte(wc * 32 + fr, fq * 8);
#define PG8_SA(b, h) (((b) * 2 + (h)) * HTB)
#define PG8_SB(b, h) ((4 + (b) * 2 + (h)) * HTB)
#define PG8_STAGE(bufoff, gbase, voff) do { _Pragma("unroll") for (int _i = 0; _i < 2; ++_i) \
        __builtin_amdgcn_global_load_lds((const unsigned*)((const char*)(gbase) + (voff)[_i]), (LAS unsigned*)(lds + (bufoff) + ldsw + _i * 8192), 16, 0, 0); } while (0)
#define PG8_STAGE_A(bufoff, base, h, GV) do { if constexpr (GATHER) { PG8_STAGE(bufoff, base, (GV)[h]); } else { PG8_STAGE(bufoff, (base) + (h) * hstep, voffA); } } while (0)
#define PG8_LD8(p) __builtin_shufflevector(*(const LAS v4i_t*)(p), *(const LAS v4i_t*)((p) + 1024), 0, 1, 2, 3, 4, 5, 6, 7)
#define PG8_LDA(dst, b, h) do { _Pragma("unroll") for (int m = 0; m < 4; ++m) { if constexpr (F8) dst##8[m] = PG8_LD8(lds + PG8_SA(b, h) + aoff + m * 2048); else { \
        _Pragma("unroll") for (int k = 0; k < 2; ++k) dst[m][k] = *(const LAS bf16x8*)(lds + PG8_SA(b, h) + aoff + m * 2048 + k * 1024); } } } while (0)
#define PG8_LDB(dst, b, h) do { _Pragma("unroll") for (int n = 0; n < 2; ++n) { if constexpr (F8) dst##8[n] = PG8_LD8(lds + PG8_SB(b, h) + boff + n * 2048); else { \
        _Pragma("unroll") for (int k = 0; k < 2; ++k) dst[n][k] = *(const LAS bf16x8*)(lds + PG8_SB(b, h) + boff + n * 2048 + k * 1024); } } } while (0)
#define PG8_MMA(ai, bj, At, Bt) do { __builtin_amdgcn_s_setprio(1); _Pragma("unroll") for (int m = 0; m < 4; ++m) _Pragma("unroll") for (int n = 0; n < 2; ++n) { \
        if constexpr (F8) { \
            asm volatile("v_mfma_scale_f32_16x16x128_f8f6f4 %0, %1, %2, %0, %3, %3 op_sel_hi:[0,0,0]" : "+v"(acc[ai][bj][m][n]) : "v"(Bt##8[n]), "v"(At##8[m]), "v"(f8one)); } \
        else { _Pragma("unroll") for (int k = 0; k < 2; ++k) acc[ai][bj][m][n] = __builtin_amdgcn_mfma_f32_16x16x32_bf16(Bt[n][k], At[m][k], acc[ai][bj][m][n], 0, 0, 0); } } \
        __builtin_amdgcn_s_setprio(0); } while (0)
#define PG8_WAIT_V(n) asm volatile("s_waitcnt vmcnt(" #n ")" ::: "memory")
#define PG8_WAIT_L(n) asm volatile("s_waitcnt lgkmcnt(" #n ")" ::: "memory")
#define PG8_BAR __builtin_amdgcn_s_barrier()
#define PG8_SCHED __builtin_amdgcn_sched_barrier(0)
#define PG8_ROWS(GV, u) do { const int* _rp = S.rows(u); _Pragma("unroll") for (int _h = 0; _h < 2; ++_h) _Pragma("unroll") for (int _i = 0; _i < 2; ++_i) \
        (GV)[_h][_i] = (unsigned)_rp[((u).h ? 0 : 128 * _h) + rA[_i]] * (unsigned)(K * 2) + cA2[_i]; } while (0)
    Unit cur, nxt; int ui = 0;
    if (!S.next(0, cur)) return;
    f32x4 acc[2][2][4][2];
#pragma unroll
    for (int a = 0; a < 2; ++a)
#pragma unroll
        for (int b = 0; b < 2; ++b)
#pragma unroll
            for (int m = 0; m < 4; ++m)
#pragma unroll
                for (int n = 0; n < 2; ++n) acc[a][b][m][n] = (f32x4){0.f, 0.f, 0.f, 0.f};
    const int f8one = 0x7f7f7f7f;
    bf16x8 At[4][2], B0[2][2], B1[2][2]; v8i_t At8[4], B08[2], B18[2];
    unsigned cv[2][2] = {{0u, 0u}, {0u, 0u}}, nv[2][2] = {{0u, 0u}, {0u, 0u}};
    const char* cA = S.a_ptr(cur); const char* cB = S.b_ptr(cur);
    if constexpr (GATHER) PG8_ROWS(cv, cur);
    PG8_STAGE(PG8_SB(0, 0), cB, voffB); PG8_STAGE(PG8_SB(0, 1), cB + hstep, voffB); PG8_STAGE_A(PG8_SA(0, 0), cA, 0, cv); PG8_STAGE_A(PG8_SA(0, 1), cA, 1, cv);
    if (wr == 1) PG8_BAR;
    PG8_WAIT_V(2); PG8_BAR;
    PG8_STAGE(PG8_SB(1, 0), cB + kstep, voffB); PG8_STAGE_A(PG8_SA(1, 0), cA + kstep, 0, cv); PG8_STAGE(PG8_SB(1, 1), cB + hstep + kstep, voffB);
    PG8_WAIT_V(6); PG8_BAR;
    for (;;) {
        const bool has_next = S.next(ui + 1, nxt);
        const char* nA = has_next ? S.a_ptr(nxt) : cA; const char* nB = has_next ? S.b_ptr(nxt) : cB;
        if constexpr (GATHER) { if (has_next) PG8_ROWS(nv, nxt); else {
#pragma unroll
            for (int h = 0; h < 2; ++h)
#pragma unroll
                for (int i = 0; i < 2; ++i) nv[h][i] = cv[h][i]; } }
        for (int t = 0; t < nt; t += 2) {
            const bool last = (t == nt - 2);
            if constexpr (Epi::MIDK) { if (t == nt / 2) { if constexpr (F8) asm volatile("s_nop 15\n\ts_nop 15" ::: "memory"); E.midk(acc, ui, wr, fr, lds); } }
            const char* a1 = cA + (size_t)(t + 1) * kstep;
            const char* a2 = last ? nA : cA + (size_t)(t + 2) * kstep; const char* b2 = last ? nB : cB + (size_t)(t + 2) * kstep;
            const char* a3 = a2 + kstep; const char* b3 = b2 + kstep;
            unsigned av[2][2];
#pragma unroll
            for (int h = 0; h < 2; ++h)
#pragma unroll
                for (int i = 0; i < 2; ++i) av[h][i] = last ? nv[h][i] : cv[h][i];
            PG8_LDB(B0, 0, 0); PG8_LDB(B1, 0, 1); PG8_SCHED; PG8_LDA(At, 0, 0); PG8_STAGE_A(PG8_SA(1, 1), a1, 1, cv);
            PG8_WAIT_V(8); PG8_WAIT_L(0); PG8_BAR; PG8_MMA(0, 0, At, B0); PG8_MMA(0, 1, At, B1); PG8_BAR; PG8_SCHED;
            if (!cur.h) PG8_LDA(At, 0, 1); PG8_STAGE(PG8_SB(0, 0), b2, voffB); PG8_STAGE(PG8_SB(0, 1), b2 + hstep, voffB); PG8_STAGE_A(PG8_SA(0, 0), a2, 0, av);
            PG8_WAIT_V(8); PG8_WAIT_L(0); PG8_BAR; if (!cur.h) { PG8_MMA(1, 0, At, B0); PG8_MMA(1, 1, At, B1); } PG8_BAR; PG8_SCHED;
            PG8_LDB(B0, 1, 0); PG8_LDB(B1, 1, 1); PG8_SCHED; PG8_LDA(At, 1, 0); PG8_STAGE_A(PG8_SA(0, 1), a2, 1, av);
            PG8_WAIT_V(8); PG8_WAIT_L(0); PG8_BAR; PG8_MMA(0, 0, At, B0); PG8_MMA(0, 1, At, B1); PG8_BAR; PG8_SCHED;
            if (!cur.h) PG8_LDA(At, 1, 1); PG8_STAGE(PG8_SB(1, 0), b3, voffB); PG8_STAGE(PG8_SB(1, 1), b3 + hstep, voffB); PG8_STAGE_A(PG8_SA(1, 0), a3, 0, av);
            PG8_WAIT_V(8); PG8_WAIT_L(0); PG8_BAR; if (!cur.h) { PG8_MMA(1, 0, At, B0); PG8_MMA(1, 1, At, B1); } PG8_BAR; PG8_SCHED;
        }
        if constexpr (F8) asm volatile("s_nop 15\n\ts_nop 15\n\ts_nop 7" ::: "memory");
        if (wr == 0) PG8_BAR;
        for (int er = 0; er < (Epi::PROBE_REP ? EPI_REPS : 1); ++er) { if constexpr (Epi::MIDK) E.fin(acc, cur, ui, wr, wc, fr, fq, lds); else E(acc, cur, wr, wc, fr, fq); }
        if (!has_next) break;
#pragma unroll
        for (int a = 0; a < 2; ++a)
#pragma unroll
            for (int b = 0; b < 2; ++b)
#pragma unroll
                for (int m = 0; m < 4; ++m)
#pragma unroll
                    for (int n = 0; n < 2; ++n) acc[a][b][m][n] = (f32x4){0.f, 0.f, 0.f, 0.f};
        cur = nxt; cA = nA; cB = nB; ++ui;
#pragma unroll
        for (int h = 0; h < 2; ++h)
#pragma unroll
            for (int i = 0; i < 2; ++i) cv[h][i] = nv[h][i];
        if (wr == 1) PG8_BAR;
    }
    PG8_WAIT_V(0);
    PG8_BAR;
#undef PG8_SA
#undef PG8_SB
#undef PG8_STAGE
#undef PG8_STAGE_A
#undef PG8_LDA
#undef PG8_LDB
#undef PG8_MMA
#undef PG8_LD8
#undef PG8_WAIT_V
#undef PG8_WAIT_L
#undef PG8_BAR
#undef PG8_SCHED
#undef PG8_ROWS
}

struct EpiQKV {
    static constexpr bool PERM = true, PROBE_REP = false, MIDK = false;
    bf16* O; bf16* KVH;
    __device__ __forceinline__ void operator()(const f32x4 (&acc)[2][2][4][2], const Unit& u, int wr, int wc, int fr, int fq) const {
        const int row0 = u.pm * BM + wr * 64 + fr;
        const bool isq = (u.pn < 4 || (u.pn >= 6 && u.pn < 10));
        const size_t tb = (u.pn == 4) ? KVH_KA : (u.pn == 5) ? KVH_VA : (u.pn < 14) ? KVH_KB + (size_t)(u.pn - 10) * 4 * NT * 64 * 2 : KVH_VB + (size_t)(u.pn - 14) * 4 * NT * 64 * 2;
        bf16* P = isq ? O : (bf16*)((unsigned char*)KVH + tb);
        const int pitch = isq ? DIN : 64; const float sc = isq ? 0.125f * LOG2E : 1.0f;
        const int cin = wc * 32 + 8 * fq;
        size_t coff[2];
#pragma unroll
        for (int bj = 0; bj < 2; ++bj) { const int c = bj * HALF + cin; coff[bj] = isq ? (size_t)(u.pn * BM + c) : ((size_t)(c >> 6) * NT * 64 + (c & 63)); }
#pragma unroll
        for (int ai = 0; ai < 2; ++ai)
#pragma unroll
            for (int m = 0; m < 4; ++m) { bf16* rowp = P + (size_t)(row0 + ai * HALF + m * 16) * pitch;
#pragma unroll
                for (int bj = 0; bj < 2; ++bj) { const f32x4 v0 = acc[ai][bj][m][0] * sc, v1 = acc[ai][bj][m][1] * sc;
                    u32x4 w; w.x = cvtpk(v0[0], v0[1]); w.y = cvtpk(v0[2], v0[3]); w.z = cvtpk(v1[0], v1[1]); w.w = cvtpk(v1[2], v1[3]);
                    *(u32x4*)(rowp + coff[bj]) = w; } }
    }
};
struct EpiRes {
    static constexpr bool PERM = true, PROBE_REP = true, MIDK = true;
    const float* X; bf16* X1; const float* mod; const float* SSQ; float* RSS;
    static constexpr int TAB_OFF = 131072;
    __device__ __forceinline__ void midk(f32x4 (&acc)[2][2][4][2], int ui, int wr, int fr, LAS unsigned char* lds) const {
        const LAS float* tab = (const LAS float*)(lds + TAB_OFF) + (size_t)ui * 512;
#pragma unroll
        for (int ai = 0; ai < 2; ++ai)
#pragma unroll
            for (int m = 0; m < 4; ++m) { const float ratio = tab[2 * (ai * HALF + wr * 64 + m * 16 + fr)];
#pragma unroll
                for (int bj = 0; bj < 2; ++bj)
#pragma unroll
                    for (int n = 0; n < 2; ++n) acc[ai][bj][m][n] = acc[ai][bj][m][n] * ratio; }
    }
    __device__ __forceinline__ void fin(const f32x4 (&acc)[2][2][4][2], const Unit& u, int ui, int wr, int wc, int fr, int fq, LAS unsigned char* lds) const {
        const LAS float* tab = (const LAS float*)(lds + TAB_OFF) + (size_t)ui * 512;
        const int row0 = u.pm * BM + wr * 64 + fr, col0 = u.pn * BM + wc * 32 + 8 * fq;
        const float* gt = mod + (size_t)(u.pm >> 4) * 16384 + 4096;
        f32x4 gv[2][2];
#pragma unroll
        for (int bj = 0; bj < 2; ++bj)
#pragma unroll
            for (int n = 0; n < 2; ++n) gv[bj][n] = *(const f32x4*)(gt + col0 + bj * HALF + 4 * n);
#pragma unroll
        for (int ai = 0; ai < 2; ++ai)
#pragma unroll
            for (int m = 0; m < 4; ++m) { const int rl = ai * HALF + wr * 64 + m * 16 + fr; const size_t off = (size_t)(u.pm * BM + rl) * DM + col0;
                const float rB = tab[2 * rl + 1];
#pragma unroll
                for (int bj = 0; bj < 2; ++bj) { const f32x4 x0 = __builtin_nontemporal_load((const f32x4*)(X + off + bj * HALF)), x1 = __builtin_nontemporal_load((const f32x4*)(X + off + bj * HALF + 4));
                    const f32x4 v0 = x0 + gv[bj][0] * (acc[ai][bj][m][0] * rB), v1 = x1 + gv[bj][1] * (acc[ai][bj][m][1] * rB);
                    u32x4 w; w.x = cvtpk(v0[0], v0[1]); w.y = cvtpk(v0[2], v0[3]); w.z = cvtpk(v1[0], v1[1]); w.w = cvtpk(v1[2], v1[3]);
                    *(u32x4*)(X1 + off + bj * HALF) = w;
                    float p = (v0[0] * v0[0] + v0[1] * v0[1]) + (v0[2] * v0[2] + v0[3] * v0[3]) + (v1[0] * v1[0] + v1[1] * v1[1]) + (v1[2] * v1[2] + v1[3] * v1[3]);
                    p += __shfl_xor(p, 16); p += __shfl_xor(p, 32);
                    if (fq == 0) RSS[(size_t)(u.pm * BM + rl) * 64 + u.pn * 8 + wc * 2 + bj] = p; }
                asm volatile("" ::: "memory"); }
        (void)row0;
    }
    __device__ __forceinline__ void operator()(const f32x4 (&)[2][2][4][2], const Unit&, int, int, int, int) const {}
};
struct EpiGU {
    static constexpr bool PERM = true, PROBE_REP = false, MIDK = false;
    unsigned char* ACT;
    __device__ __forceinline__ void operator()(const f32x4 (&acc)[2][2][4][2], const Unit& u, int wr, int wc, int fr, int fq) const {
        const int row0 = u.r0 + wr * 64 + fr, col0 = u.pn * 128 + wc * 32 + 8 * fq; constexpr float us = 1.0f / (F8_SH * F8_SWGU);
#pragma unroll
        for (int ai = 0; ai < 2; ++ai) { if (ai == 1 && u.h) break;
#pragma unroll
            for (int m = 0; m < 4; ++m) { float r[8];
#pragma unroll
                for (int n = 0; n < 2; ++n)
#pragma unroll
                    for (int j = 0; j < 4; ++j) { const float g = acc[ai][0][m][n][j] * us, up = acc[ai][1][m][n][j] * us;
                        r[4 * n + j] = g * __builtin_amdgcn_rcpf(1.0f + __expf(-g)) * up * F8_SACT; }
                u32x2 w; w.x = cvt4_fp8(r[0], r[1], r[2], r[3]); w.y = cvt4_fp8(r[4], r[5], r[6], r[7]);
                *(u32x2*)(ACT + (size_t)(row0 + ai * HALF + m * 16) * DE + col0) = w; } }
    }
};
struct EpiY {
    static constexpr bool PERM = true, PROBE_REP = false, MIDK = false;
    unsigned char* Y;
    __device__ __forceinline__ void operator()(const f32x4 (&acc)[2][2][4][2], const Unit& u, int wr, int wc, int fr, int fq) const {
        const int row0 = u.r0 + wr * 64 + fr, col0 = u.pn * BM + wc * 32 + 8 * fq;
#pragma unroll
        for (int ai = 0; ai < 2; ++ai) { if (ai == 1 && u.h) break;
#pragma unroll
            for (int m = 0; m < 4; ++m) { unsigned char* rowp = Y + (size_t)(row0 + ai * HALF + m * 16) * DM + col0;
#pragma unroll
                for (int bj = 0; bj < 2; ++bj) { constexpr float us = F8_SY / (F8_SACT * F8_SWD); const f32x4 v0 = acc[ai][bj][m][0] * us, v1 = acc[ai][bj][m][1] * us;
                    u32x2 w; w.x = cvt4_fp8(v0[0], v0[1], v0[2], v0[3]); w.y = cvt4_fp8(v1[0], v1[1], v1[2], v1[3]);
                    *(u32x2*)(rowp + bj * HALF) = w; } } }
    }
};
}

struct Args { const float* in[22]; float* out; unsigned char* ws; int ph_lo, ph_hi; };
struct InPtrs {
    __device__ __forceinline__ const float* operator[](int k) const {
        const __attribute__((address_space(4))) char* p = (const __attribute__((address_space(4))) char*)__builtin_amdgcn_kernarg_segment_ptr();
        asm volatile("" : "+s"(p));
        return *(const float* const __attribute__((address_space(4)))*)(p + 8 * k);
    }
};
struct Ctx { InPtrs in; float* out; unsigned char* ws; };
static_assert(__builtin_offsetof(Args, in) == 0, "InPtrs reads Args::in at kernarg offset 0");
enum { I_X = 0, I_C, I_WADA, I_BADA, I_GMIX, I_WIN, I_SINKS, I_RELB, I_GOA, I_GOB, I_WOUT, I_GFFN, I_WRG, I_BRG, I_WRE, I_BRE, I_WGATE, I_WUP, I_WDOWN, I_WADAF, I_BADAF, I_GFIN };

__device__ __forceinline__ void p0_mod(const Ctx& a, LAS unsigned char* lds, int tid, int lane, int wave) {
    LAS float* cact = (LAS float*)lds;
    LAS float* red = (LAS float*)(lds + 32768);
    const float* c = a.in[I_C];
    for (int i = tid; i < 2048 * 4; i += 512) { const int b = i >> 11, k = i & 2047; const float v = c[i]; cact[k * 4 + b] = v / (1.0f + __expf(-v)); }
    __syncthreads();
    float* mod = (float*)(a.ws + WS_MOD);
    const int rsub = lane >> 4, cq = lane & 15;
    for (int cg = blockIdx.x; cg < 256; cg += gridDim.x) {
        const int col0 = cg * 64;
        const float* W; int ldw; const float* bias; int cc;
        if (col0 < 12288) { W = a.in[I_WADA]; ldw = 12288; bias = a.in[I_BADA]; cc = col0; } else { W = a.in[I_WADAF]; ldw = 4096; bias = a.in[I_BADAF]; cc = col0 - 12288; }
        float acc[4][4];
#pragma unroll
        for (int b = 0; b < 4; ++b)
#pragma unroll
            for (int j = 0; j < 4; ++j) acc[b][j] = 0.f;
        const float* wp = W + (size_t)(wave * 256 + rsub) * ldw + cc + 4 * cq;
#pragma unroll 8
        for (int i = 0; i < 64; ++i) {
            const f32x4 wv = __builtin_nontemporal_load((const f32x4*)(wp + (size_t)(4 * i) * ldw));
            const f32x4 ca = *(const LAS f32x4*)(cact + (wave * 256 + 4 * i + rsub) * 4);
#pragma unroll
            for (int b = 0; b < 4; ++b)
#pragma unroll
                for (int j = 0; j < 4; ++j) acc[b][j] += ca[b] * wv[j];
        }
#pragma unroll
        for (int b = 0; b < 4; ++b)
#pragma unroll
            for (int j = 0; j < 4; ++j) { float v = acc[b][j]; v += __shfl_xor(v, 16); v += __shfl_xor(v, 32); if (lane < 16) red[(wave * 4 + b) * 64 + 4 * cq + j] = v; }
        __syncthreads();
        if (tid < 256) { const int b = tid >> 6, col = tid & 63; float s = bias[cc + col];
#pragma unroll
            for (int w = 0; w < 8; ++w) s += red[(w * 4 + b) * 64 + col];
            __hip_atomic_store(&mod[(size_t)b * 16384 + col0 + col], s, __ATOMIC_RELAXED, __HIP_MEMORY_SCOPE_AGENT); }
        asm volatile("s_waitcnt vmcnt(0)" ::: "memory");
        __syncthreads();
        if (tid == 0) __hip_atomic_fetch_add((unsigned*)(a.ws + WS_CTL) + MOD_CTR, 1u, __ATOMIC_RELAXED, __HIP_MEMORY_SCOPE_AGENT);
    }
}
__device__ __forceinline__ void mod_wait(const Ctx& a, int tid) {
    if (tid == 0) { unsigned* ctr = (unsigned*)(a.ws + WS_CTL) + MOD_CTR; unsigned sp = 0;
        while (__hip_atomic_load(ctr, __ATOMIC_RELAXED, __HIP_MEMORY_SCOPE_AGENT) < 256u) { __builtin_amdgcn_s_sleep(2); if (++sp > (1u << 22)) break; }
        __builtin_amdgcn_fence(__ATOMIC_ACQUIRE, "agent");
        asm volatile("s_waitcnt vmcnt(0)" ::: "memory"); }
    __syncthreads();
}
template <bool NTS>
__device__ __forceinline__ void transpose_item(const float* W, int ldw, int k0, int n0, const float* kscale, bf16* dst, int Kd, LAS float* scr, int lane) {
    const int r = lane >> 4, q = lane & 15;
#pragma unroll 4
    for (int i = 0; i < 16; ++i) { const int kk = 4 * i + r; f32x4 v = __builtin_nontemporal_load((const f32x4*)(W + (size_t)(k0 + kk) * ldw + n0 + 4 * q));
        if (kscale) { const float s = kscale[k0 + kk]; v = v * s; }
        LAS float* sp = scr + kk * 65 + 4 * q; sp[0] = v[0]; sp[1] = v[1]; sp[2] = v[2]; sp[3] = v[3]; }
    LDS_WAIT();
    const int c = lane & 7;
#pragma unroll
    for (int j = 0; j < 8; ++j) { const int n = (lane >> 3) + 8 * j; const LAS float* s = scr + (8 * c) * 65 + n;
        u32x4 o; o.x = cvtpk(s[0 * 65], s[1 * 65]); o.y = cvtpk(s[2 * 65], s[3 * 65]); o.z = cvtpk(s[4 * 65], s[5 * 65]); o.w = cvtpk(s[6 * 65], s[7 * 65]);
        if (NTS) __builtin_nontemporal_store(o, (u32x4*)(dst + (size_t)n * Kd + 8 * c)); else *(u32x4*)(dst + (size_t)n * Kd + 8 * c) = o; }
    LDS_WAIT();
}
template <bool NTS>
__device__ __forceinline__ void transpose_item8(const float* W, int ldw, int k0, int n0, float scale, const float* kscale, unsigned char* dst8, int Kd, LAS float* scr, int lane) {
    const int r = lane >> 3, q = lane & 7;
    f32x4 v[16];
#pragma unroll
    for (int i = 0; i < 16; ++i) v[i] = __builtin_nontemporal_load((const f32x4*)(W + (size_t)(k0 + 8 * i + r) * ldw + n0 + 4 * q));
#pragma unroll
    for (int i = 0; i < 16; ++i) { if (kscale) v[i] = v[i] * kscale[k0 + 8 * i + r]; LAS float* sp = scr + (8 * i + r) * 33 + 4 * q; sp[0] = v[i][0]; sp[1] = v[i][1]; sp[2] = v[i][2]; sp[3] = v[i][3]; }
    LDS_WAIT();
    const int c = lane >> 3, nl = lane & 7;
#pragma unroll
    for (int j = 0; j < 4; ++j) { const int n = nl + 8 * j; const LAS float* sq = scr + (16 * c) * 33 + n; u32x4 o;
        o.x = cvt4_fp8(sq[0 * 33] * scale, sq[1 * 33] * scale, sq[2 * 33] * scale, sq[3 * 33] * scale); o.y = cvt4_fp8(sq[4 * 33] * scale, sq[5 * 33] * scale, sq[6 * 33] * scale, sq[7 * 33] * scale);
        o.z = cvt4_fp8(sq[8 * 33] * scale, sq[9 * 33] * scale, sq[10 * 33] * scale, sq[11 * 33] * scale); o.w = cvt4_fp8(sq[12 * 33] * scale, sq[13 * 33] * scale, sq[14 * 33] * scale, sq[15 * 33] * scale);
        if (NTS) __builtin_nontemporal_store(o, (u32x4*)(dst8 + (size_t)n * Kd + 16 * c)); else *(u32x4*)(dst8 + (size_t)n * Kd + 16 * c) = o; }
    LDS_WAIT();
}
constexpr int CV_IN = 32 * 72, CV_OUT = 32 * 32, CV_G = 32 * 256, CV_D = 32 * 256;
constexpr int CV_UP0 = CV_IN + CV_OUT + CV_G, CV_DN0 = CV_UP0 + CV_G, CV_ALL = CV_DN0 + CV_D;
constexpr int CV_G_P4L = CV_IN + CV_OUT + 8 * 256;
constexpr int CV_G_P4 = CV_IN + CV_OUT + 20 * 256;
constexpr int CV_UP_TAIL = CV_UP0 + 10 * 256, CV_DN_TAIL = CV_DN0 + 0 * 256;
__device__ __forceinline__ void convert_items(const Ctx& a, LAS unsigned char* lds, int lane, int wave, int first, int last, int gw, int NGW) {
    LAS float* scr = (LAS float*)(lds + wave * 16896);
    bf16* WinT = (bf16*)(a.ws + WS_WIN); unsigned char* WoutT = a.ws + WS_WOUT; unsigned char* WguT = a.ws + WS_WGU; unsigned char* WdT = a.ws + WS_WD;
    for (int it = first + gw; it < last; it += NGW) {
        int r = it;
        if (r < CV_IN) { const int kb = r / 72, nb = r % 72; transpose_item<false>(a.in[I_WIN], DIN, 64 * kb, 64 * nb, nullptr, WinT + (size_t)(64 * nb) * DM + 64 * kb, DM, scr, lane); continue; } r -= CV_IN;
        if (r < CV_OUT) { const int kb = r >> 6, nb = r & 63; const float* ks = (kb < 8) ? a.in[I_GOA] : (a.in[I_GOB] - 1024);
            transpose_item8<true>(a.in[I_WOUT], DM, 128 * kb, 32 * nb, F8_SWO, ks, WoutT + (size_t)(32 * nb) * DM + 128 * kb, DM, scr, lane); continue; } r -= CV_OUT;
        if (r < 2 * CV_G) { const int up = r >= CV_G ? 1 : 0; if (up) r -= CV_G; const int e = r >> 8, rr = r & 255, kb = rr >> 4, nb = rr & 15, n0 = 32 * nb;
            const int drow = 256 * (n0 >> 7) + (n0 & 127) + 128 * up;
            transpose_item8<true>(a.in[up ? I_WUP : I_WGATE] + (size_t)e * DM * DE, DE, 128 * kb, n0, F8_SWGU, nullptr, WguT + ((size_t)e * 1024 + drow) * DM + 128 * kb, DM, scr, lane); continue; } r -= 2 * CV_G;
        { const int e = r >> 8, rr = r & 255, kb = rr >> 6, nb = rr & 63;
            transpose_item8<true>(a.in[I_WDOWN] + (size_t)e * DE * DM, DM, 128 * kb, 32 * nb, F8_SWD, nullptr, WdT + ((size_t)e * DM + 32 * nb) * DE + 128 * kb, DE, scr, lane); }
    }
}
__device__ __forceinline__ void p0_convert(const Ctx& a, LAS unsigned char* lds, int tid, int lane, int wave) {
    convert_items(a, lds, lane, wave, 0, CV_IN + CV_OUT, blockIdx.x * 8 + wave, gridDim.x * 8);
    if (gridDim.x != 256) { convert_items(a, lds, lane, wave, CV_IN + CV_OUT, CV_G_P4L, blockIdx.x * 8 + wave, gridDim.x * 8); convert_items(a, lds, lane, wave, CV_UP0, CV_UP_TAIL, blockIdx.x * 8 + wave, gridDim.x * 8); }
    convert_items(a, lds, lane, wave, CV_DN0, CV_DN_TAIL, blockIdx.x * 8 + wave, gridDim.x * 8);
    bf16* wrhi = (bf16*)(a.ws + WS_WRT); bf16* wrlo = wrhi + 48 * 2048;
    for (int i = blockIdx.x * 512 + tid; i < 48 * 2048; i += gridDim.x * 512) { const int col = i >> 11, k = i & 2047;
        const float v = col < 4 ? a.in[I_WRG][k * 4 + col] : (col < 36 ? a.in[I_WRE][k * 32 + col - 4] : 0.f);
        const unsigned h = cvtpk(v, 0.f); const float hf = bf_lo(h); const unsigned l = cvtpk(v - hf, 0.f);
        wrhi[i] = (bf16)(h & 0xffffu); wrlo[i] = (bf16)(l & 0xffffu); }
}

__device__ __forceinline__ void p1_norm(const Ctx& a, int lane, int wave) {
    const float* x = a.in[I_X]; const float* g = a.in[I_GMIX]; const float* mod = (const float*)(a.ws + WS_MOD); bf16* H = (bf16*)(a.ws + WS_H);
    const int gw = blockIdx.x * 8 + wave, NGW = gridDim.x * 8;
    { float* aux = (float*)(a.ws + WS_AUX);
      for (int i = gw; i < 4 * 36; i += NGW) { const int b = i / 36, c = i % 36; const float* sh = mod + (size_t)b * 16384 + 6144; float sacc = 0.f;
          for (int k = lane; k < DM; k += 64) sacc += sh[k] * (c < 4 ? a.in[I_WRG][k * 4 + c] : a.in[I_WRE][k * 32 + c - 4]);
          sacc = wave_sum(sacc); if (lane == 0) aux[b * 48 + c] = sacc + (c < 4 ? a.in[I_BRG][c] : a.in[I_BRE][c - 4]); }
      for (int i = blockIdx.x * 512 + threadIdx.x; i < 4 * DM; i += gridDim.x * 512) { const int b = i >> 11, k = i & 2047; aux[1024 + i] = a.in[I_GFFN][k] * (1.0f + mod[(size_t)b * 16384 + 8192 + k]); } }
    for (int grp = gw; grp < NT / 8; grp += NGW) {
        const int row0 = grp * 8, b = row0 >> 12;
        f32x4 A[8];
        const float* shp = mod + (size_t)b * 16384 + 4 * lane;
#pragma unroll
        for (int j = 0; j < 8; ++j) { const int k = 4 * lane + 256 * j; const f32x4 gg = *(const f32x4*)(g + k), sc = *(const f32x4*)(mod + (size_t)b * 16384 + 2048 + k);
            A[j] = gg * (1.0f + sc); }
        f32x4 vb[2][8];
#pragma unroll
        for (int j = 0; j < 8; ++j) vb[0][j] = __builtin_nontemporal_load((const f32x4*)(x + (size_t)row0 * DM + 4 * lane + 256 * j));
#pragma unroll
        for (int r = 0; r < 8; ++r) {
            if (r + 1 < 8) {
#pragma unroll
                for (int j = 0; j < 8; ++j) vb[(r + 1) & 1][j] = __builtin_nontemporal_load((const f32x4*)(x + (size_t)(row0 + r + 1) * DM + 4 * lane + 256 * j)); }
            float s = 0.f;
#pragma unroll
            for (int j = 0; j < 8; ++j) { const f32x4 v = vb[r & 1][j]; s += (v[0] * v[0] + v[1] * v[1]) + (v[2] * v[2] + v[3] * v[3]); }
            const float rstd = __builtin_amdgcn_rsqf(wave_sum(s) * (1.0f / DM) + EPS);
            bf16* hr = H + (size_t)(row0 + r) * DM + 4 * lane;
#pragma unroll
            for (int j = 0; j < 8; ++j) { const f32x4 h = vb[r & 1][j] * rstd * A[j] + *(const f32x4*)(shp + 256 * j); u32x2 w; w.x = cvtpk(h[0], h[1]); w.y = cvtpk(h[2], h[3]); *(u32x2*)(hr + 256 * j) = w; }
        }
    }
}

__device__ __forceinline__ void att_glds16(unsigned voff, const void* sbase, unsigned lds_dst) { unsigned keep;
    asm volatile("s_mov_b32 %0, m0\n\ts_mov_b32 m0, %3\n\ts_nop 0\n\tglobal_load_lds_dwordx4 %1, %2\n\ts_mov_b32 m0, %0" : "=&s"(keep) : "v"(voff), "s"(sbase), "s"(lds_dst) : "memory"); }
__device__ __forceinline__ void att_dma_tile(const bf16* base, unsigned lds0, unsigned vo0, unsigned vo1) {
    unsigned keep;
#pragma unroll
    for (int h = 0; h < 2; ++h) {
        asm volatile("s_mov_b32 %0, m0\n\ts_mov_b32 m0, %4\n\ts_nop 0\n\t"
                     "global_load_lds_dwordx4 %1, %3\n\tglobal_load_lds_dwordx4 %2, %3 offset:1024\n\tglobal_load_lds_dwordx4 %1, %3 offset:2048\n\tglobal_load_lds_dwordx4 %2, %3 offset:3072\n\t"
                     "s_mov_b32 m0, %0" : "=&s"(keep) : "v"(vo0), "v"(vo1), "s"(base), "s"(lds0) : "memory");
        base += 4 * 8 * 64; lds0 += 4096u; asm volatile("" : "+s"(base), "+s"(lds0));
    }
}
#define ATT_DMAK(KB) att_dma_tile((KB), klu, kvo0, kvo0 ^ 64u)
#define ATT_DMAV(VB) att_dma_tile((VB), klu + 8192u, vvo, vvo)
__device__ __forceinline__ void att_scores(f32x16& s0, f32x16& s1, const bf16x8 (&qf)[4], const LAS unsigned char* kfp, int hh, int km, const LAS float* tbl,
                                           bool isA, int dd, float nslope2, float cb, int base0, float moff) {
    int bl = base0; asm volatile("" : "+v"(bl));
    const float fbl = (float)bl; float cadd = 0.f;
    if (isA) {
        if (dd > 0) { const float c00 = nslope2 * (fbl + 64.0f * (float)dd) - moff, c01 = c00 - 32.0f * nslope2;
#pragma unroll
            for (int r = 0; r < 16; ++r) { const float noff = -(float)((r & 3) + 8 * (r >> 2)); s0[r] = fmaf(nslope2, noff, c00); s1[r] = fmaf(nslope2, noff, c01); } }
        else { const float nm = -moff;
#pragma unroll
            for (int r = 0; r < 16; ++r) { const float off = (float)((r & 3) + 8 * (r >> 2)); s0[r] = fmaf(nslope2, fabsf(fbl - off), nm); s1[r] = fmaf(nslope2, fabsf(fbl - (off + 32.0f)), nm); } }
    } else if (dd >= 3) { cadd = cb - moff;
#pragma unroll
        for (int r = 0; r < 16; ++r) { s0[r] = 0.f; s1[r] = 0.f; }
    } else {
        const LAS float* p0 = tbl + (bl + 64 * dd + 64 - 27); const LAS float* p1 = p0 - 32;
#pragma unroll
        for (int r = 0; r < 16; ++r) { s0[r] = p0[27 - ((r & 3) + 8 * (r >> 2))] - moff; s1[r] = p1[27 - ((r & 3) + 8 * (r >> 2))] - moff; } }
    bf16x8 kf[8];
#pragma unroll
    for (int kt = 0; kt < 2; ++kt)
#pragma unroll
        for (int ks = 0; ks < 4; ++ks) kf[4 * kt + ks] = *(const LAS bf16x8*)(kfp + kt * 4096 + (((2 * ks + hh) ^ km) << 4));
#pragma unroll
    for (int ks = 0; ks < 4; ++ks) { s0 = __builtin_amdgcn_mfma_f32_32x32x16_bf16(kf[ks], qf[ks], s0, 0, 0, 0); s1 = __builtin_amdgcn_mfma_f32_32x32x16_bf16(kf[4 + ks], qf[ks], s1, 0, 0, 0); }
    if (!isA && dd >= 3) {
#pragma unroll
        for (int r = 0; r < 16; ++r) { s0[r] += cadd; s1[r] += cadd; } }
}
constexpr float ATT_THR = 4.0f;
template <bool FIRSTHALF>
__device__ __forceinline__ void att_softmax_pv(f32x16& s0, f32x16& s1, f32x16& o0, f32x16& o1, float& m2, float& l, const LAS unsigned char* vl, int tr0, bool first) {
    float mx = fmaxf(s0[0], s1[0]);
#pragma unroll
    for (int r = 1; r < 16; ++r) mx = fmaxf(fmaxf(mx, s0[r]), s1[r]);
    { const auto rr = __builtin_amdgcn_permlane32_swap(__float_as_uint(mx), __float_as_uint(mx), false, false); mx = fmaxf(__uint_as_float(rr[0]), __uint_as_float(rr[1])); }
    if (first || __any(mx > ATT_THR)) {
        float delta;
        if (first) { delta = mx; m2 = mx; }
        else { delta = fmaxf(mx, 0.f); m2 += delta; const float alpha = __builtin_amdgcn_exp2f(-delta); l *= alpha;
#pragma unroll
            for (int r = 0; r < 16; ++r) { float a0 = o0[r], a1 = o1[r]; asm volatile("v_mul_f32 %0, %2, %0\n\tv_mul_f32 %1, %2, %1" : "+v"(a0), "+v"(a1) : "v"(alpha)); o0[r] = a0; o1[r] = a1; } }
#pragma unroll
        for (int r = 0; r < 16; ++r) { float a0 = s0[r], a1 = s1[r]; asm volatile("v_sub_f32 %0, %0, %2\n\tv_sub_f32 %1, %1, %2" : "+v"(a0), "+v"(a1) : "v"(delta)); s0[r] = a0; s1[r] = a1; }
    }
    float rs = 0.f;
#pragma unroll
    for (int r = 0; r < 16; ++r) { s0[r] = __builtin_amdgcn_exp2f(s0[r]); s1[r] = __builtin_amdgcn_exp2f(s1[r]); rs += s0[r] + s1[r]; }
    l += rs;
    bf16x8 pb[2][2];
#pragma unroll
    for (int s = 0; s < 2; ++s) {
        u32x4 w0, w1;
        w0.x = cvtpk(s0[8 * s + 0], s0[8 * s + 1]); w0.y = cvtpk(s0[8 * s + 2], s0[8 * s + 3]); w0.z = cvtpk(s0[8 * s + 4], s0[8 * s + 5]); w0.w = cvtpk(s0[8 * s + 6], s0[8 * s + 7]);
        w1.x = cvtpk(s1[8 * s + 0], s1[8 * s + 1]); w1.y = cvtpk(s1[8 * s + 2], s1[8 * s + 3]); w1.z = cvtpk(s1[8 * s + 4], s1[8 * s + 5]); w1.w = cvtpk(s1[8 * s + 6], s1[8 * s + 7]);
        pb[0][s] = __builtin_bit_cast(bf16x8, w0); pb[1][s] = __builtin_bit_cast(bf16x8, w1); }
    if (FIRSTHALF) asm volatile("s_waitcnt vmcnt(0)" ::: "memory");
#pragma unroll
    for (int kt = 0; kt < 2; ++kt)
#pragma unroll
        for (int s = 0; s < 2; ++s)
#pragma unroll
            for (int dt = 0; dt < 2; ++dt) {
                const LAS unsigned char* ap = vl + (dt ? (tr0 ^ 64) : tr0) + (32 * kt + 16 * s) * 128;
                const s16x4 r1 = __builtin_bit_cast(s16x4, __builtin_amdgcn_ds_read_tr16_b64_v4i16((LAS s16x4*)ap));
                const s16x4 r2 = __builtin_bit_cast(s16x4, __builtin_amdgcn_ds_read_tr16_b64_v4i16((LAS s16x4*)(ap + 8 * 128)));
                const bf16x8 av = {r1[0], r1[1], r1[2], r1[3], r2[0], r2[1], r2[2], r2[3]};
                if (dt == 0) o0 = __builtin_amdgcn_mfma_f32_32x32x16_bf16(av, pb[kt][s], o0, 0, 0, 0);
                else o1 = __builtin_amdgcn_mfma_f32_32x32x16_bf16(av, pb[kt][s], o1, 0, 0, 0); }
}
__device__ __forceinline__ void att_scores2(f32x16& sA, f32x16& sB, const bf16x8 (&qa)[4], const bf16x8 (&qb)[4], const LAS unsigned char* kfp, const int kt, int hh, int km, const LAS float* tbl,
                                            bool isA, int dd, float nslope2, float cb, int base0, float moffA, float moffB) {
    int bl = base0; asm volatile("" : "+v"(bl));
    const float fbl = (float)bl; float caddA = 0.f, caddB = 0.f;
    if (isA) {
        if (dd > 0) { const float cA = nslope2 * (fbl + 64.0f * (float)dd - 32.0f * (float)kt) - moffA, cB = nslope2 * (fbl + 32.0f + 64.0f * (float)dd - 32.0f * (float)kt) - moffB;
#pragma unroll
            for (int r = 0; r < 16; ++r) { const float noff = -(float)((r & 3) + 8 * (r >> 2)); sA[r] = fmaf(nslope2, noff, cA); sB[r] = fmaf(nslope2, noff, cB); } }
        else { const float nA = -moffA, nB = -moffB;
#pragma unroll
            for (int r = 0; r < 16; ++r) { const float off = (float)((r & 3) + 8 * (r >> 2) + 32 * kt); sA[r] = fmaf(nslope2, fabsf(fbl - off), nA); sB[r] = fmaf(nslope2, fabsf(fbl + 32.0f - off), nB); } }
    } else if (dd >= 3) { caddA = cb - moffA; caddB = cb - moffB;
#pragma unroll
        for (int r = 0; r < 16; ++r) { sA[r] = 0.f; sB[r] = 0.f; }
    } else {
        const LAS float* pA = tbl + (bl + 64 * dd + 64 - 27 - 32 * kt); const LAS float* pB = pA + 32;
#pragma unroll
        for (int r = 0; r < 16; ++r) { sA[r] = pA[27 - ((r & 3) + 8 * (r >> 2))] - moffA; sB[r] = pB[27 - ((r & 3) + 8 * (r >> 2))] - moffB; } }
    bf16x8 kf[4];
#pragma unroll
    for (int ks = 0; ks < 4; ++ks) kf[ks] = *(const LAS bf16x8*)(kfp + kt * 4096 + (((2 * ks + hh) ^ km) << 4));
#pragma unroll
    for (int ks = 0; ks < 4; ++ks) { sA = __builtin_amdgcn_mfma_f32_32x32x16_bf16(kf[ks], qa[ks], sA, 0, 0, 0); sB = __builtin_amdgcn_mfma_f32_32x32x16_bf16(kf[ks], qb[ks], sB, 0, 0, 0); }
    if (!isA && dd >= 3) {
#pragma unroll
        for (int r = 0; r < 16; ++r) { sA[r] += caddA; sB[r] += caddB; } }
}
__device__ __forceinline__ void att_softmax1(f32x16& sv, f32x16& o0, f32x16& o1, float& m2, float& l, bool first, bf16x8 (&p)[2]) {
    float mx = fmaxf(sv[0], sv[1]);
#pragma unroll
    for (int r = 2; r < 16; r += 2) mx = fmaxf(fmaxf(mx, sv[r]), sv[r + 1]);
    { const auto rr = __builtin_amdgcn_permlane32_swap(__float_as_uint(mx), __float_as_uint(mx), false, false); mx = fmaxf(__uint_as_float(rr[0]), __uint_as_float(rr[1])); }
    if (first || __any(mx > ATT_THR)) {
        float delta;
        if (first) { delta = mx; m2 = mx; }
        else { delta = fmaxf(mx, 0.f); m2 += delta; const float alpha = __builtin_amdgcn_exp2f(-delta); l *= alpha;
#pragma unroll
            for (int r = 0; r < 16; ++r) { float a0 = o0[r], a1 = o1[r]; asm volatile("v_mul_f32 %0, %2, %0\n\tv_mul_f32 %1, %2, %1" : "+v"(a0), "+v"(a1) : "v"(alpha)); o0[r] = a0; o1[r] = a1; } }
#pragma unroll
        for (int r = 0; r < 16; ++r) { float a0 = sv[r]; asm volatile("v_sub_f32 %0, %0, %1" : "+v"(a0) : "v"(delta)); sv[r] = a0; }
    }
    float rs = 0.f;
#pragma unroll
    for (int r = 0; r < 16; ++r) { sv[r] = __builtin_amdgcn_exp2f(sv[r]); rs += sv[r]; }
    l += rs;
#pragma unroll
    for (int k2 = 0; k2 < 2; ++k2) { u32x4 w; w.x = cvtpk(sv[8 * k2 + 0], sv[8 * k2 + 1]); w.y = cvtpk(sv[8 * k2 + 2], sv[8 * k2 + 3]); w.z = cvtpk(sv[8 * k2 + 4], sv[8 * k2 + 5]); w.w = cvtpk(sv[8 * k2 + 6], sv[8 * k2 + 7]);
        p[k2] = __builtin_bit_cast(bf16x8, w); }
}
__device__ __forceinline__ void att_pv2(const int kt, const bf16x8 (&pA)[2], const bf16x8 (&pB)[2], f32x16& oa0, f32x16& oa1, f32x16& ob0, f32x16& ob1, const LAS unsigned char* vl, int tr0) {
#pragma unroll
    for (int k2 = 0; k2 < 2; ++k2)
#pragma unroll
        for (int dt = 0; dt < 2; ++dt) {
            const LAS unsigned char* ap = vl + (dt ? (tr0 ^ 64) : tr0) + (32 * kt + 16 * k2) * 128;
            const s16x4 r1 = __builtin_bit_cast(s16x4, __builtin_amdgcn_ds_read_tr16_b64_v4i16((LAS s16x4*)ap));
            const s16x4 r2 = __builtin_bit_cast(s16x4, __builtin_amdgcn_ds_read_tr16_b64_v4i16((LAS s16x4*)(ap + 8 * 128)));
            const bf16x8 av = {r1[0], r1[1], r1[2], r1[3], r2[0], r2[1], r2[2], r2[3]};
            if (dt == 0) { oa0 = __builtin_amdgcn_mfma_f32_32x32x16_bf16(av, pA[k2], oa0, 0, 0, 0); ob0 = __builtin_amdgcn_mfma_f32_32x32x16_bf16(av, pB[k2], ob0, 0, 0, 0); }
            else { oa1 = __builtin_amdgcn_mfma_f32_32x32x16_bf16(av, pA[k2], oa1, 0, 0, 0); ob1 = __builtin_amdgcn_mfma_f32_32x32x16_bf16(av, pB[k2], ob1, 0, 0, 0); } }
}
__device__ __forceinline__ void p3_attn(const Ctx& a, LAS unsigned char* lds, int tid, int lane, int wave) {
    const bf16* qkv = (const bf16*)(a.ws + WS_QKV); unsigned char* O = a.ws + WS_O;
    const unsigned char* kvh = a.ws + WS_KVH;
    const float* sinks = a.in[I_SINKS]; const float* relb = a.in[I_RELB];
    LAS unsigned char* kl = lds + wave * 16384;
    LAS unsigned char* vl = kl + 8192;
    LAS float* tbl = (LAS float*)(lds + 131072 + wave * 1056);
    LAS float* ssqp = (LAS float*)(lds + 131072 + 8 * 1056);
    LAS float* rstd = (LAS float*)(lds + 131072 + 8 * 1056 + 8192);
    static_assert(131072 + 8 * 1056 + 8192 + 512 <= MISC_OFF, "attention LDS map");
    const int l31 = lane & 31, hh = lane >> 5;
    const int grp = lane >> 4, i16 = lane & 15;
    const int base0 = l31 - 4 * hh;
    const int vrow = lane >> 3, vch = lane & 7;
    const unsigned kvo0 = (unsigned)(vrow * 64 + 8 * (vch ^ ((lane >> 4) & 7))) * 2u, vvo = (unsigned)(vrow * 64 + 8 * (vch ^ (4 * ((lane >> 4) & 1)))) * 2u;
    const int km = (l31 >> 1) & 7, kro = l31 * 128;
    const int trrow = (4 * hh + (i16 >> 2)) * 128, trc0 = (2 * (grp & 1) + ((i16 & 3) >> 1)) ^ (4 * ((i16 >> 3) & 1));
    const int tr0 = trrow + trc0 * 16 + (i16 & 1) * 8;
    for (int u0 = blockIdx.x; u0 < 256; u0 += gridDim.x) {
        const int unit = (gridDim.x == 256) ? ((u0 & 7) * 32 + (u0 >> 3)) : u0;
        const int b = unit >> 6, ci = unit & 63, tok0 = b * SEQ + ci * 64;
        const int dmaxA = ci < 2 ? ci : 2, dmaxB = ci < 8 ? ci : 8;
        {
            const unsigned klu = (unsigned)(__UINTPTR_TYPE__)kl;
            const int kvn = wave >> 2, ktok0 = tok0 - 64 * (ci % (dmaxA + 1));
            const bf16* kp = (const bf16*)(kvh + KVH_KA) + ((size_t)kvn * NT + ktok0) * 64; ATT_DMAK(kp);
            const bf16* vp = (const bf16*)(kvh + KVH_VA) + ((size_t)kvn * NT + ktok0) * 64; ATT_DMAV(vp);
        }
        bf16x8 qn0[4], qn1[4];
        { const bf16* qp = qkv + (size_t)(tok0 + l31) * DIN + COL_QA + wave * 64 + 8 * hh;
#pragma unroll
          for (int ks = 0; ks < 4; ++ks) { qn0[ks] = __builtin_nontemporal_load((const bf16x8*)(qp + 16 * ks)); qn1[ks] = __builtin_nontemporal_load((const bf16x8*)(qp + (size_t)32 * DIN + 16 * ks)); } }
        for (int it = 0; it < 4; ++it) {
            const int head = wave + 8 * it;
            const bool isA = it < 2;
            bf16x8 qf0[4], qf1[4];
            asm volatile("" :: "v"(qn0[0]), "v"(qn0[1]), "v"(qn0[2]), "v"(qn0[3]), "v"(qn1[0]), "v"(qn1[1]), "v"(qn1[2]), "v"(qn1[3]));
#pragma unroll
            for (int ks = 0; ks < 4; ++ks) { qf0[ks] = qn0[ks]; qf1[ks] = qn1[ks]; }
            const bf16 *kb0, *vb0; int dmax; float m2a, la, nslope2 = 0.f, cb = 0.f;
            if (isA) { const size_t ho = ((size_t)(head >> 2) * NT + tok0) * 64; kb0 = (const bf16*)(kvh + KVH_KA) + ho; vb0 = (const bf16*)(kvh + KVH_VA) + ho; dmax = dmaxA;
                m2a = sinks[head] * LOG2E; la = hh == 0 ? 1.0f : 0.f; nslope2 = -__builtin_amdgcn_exp2f(-0.5f * (float)(head + 1)) * LOG2E; }
            else { const int hb = head - 16; const size_t ho = ((size_t)hb * NT + tok0) * 64; kb0 = (const bf16*)(kvh + KVH_KB) + ho; vb0 = (const bf16*)(kvh + KVH_VB) + ho; dmax = dmaxB; m2a = -1e30f; la = 0.f;
                for (int i = lane; i < 256; i += 64) { const int rel = i - 64; tbl[i] = relb[hb * 257 + (rel > 128 ? 128 : rel) + 128] * LOG2E; }
                cb = relb[hb * 257 + 256] * LOG2E; }
            float m2b = m2a, lb = la;
            const int nhead = head + 8; const bool nA = (it + 1) < 2;
            const size_t nho = ((size_t)(nA ? (nhead >> 2) : (nhead - 16)) * NT + tok0) * 64;
            const int nrot = ci % ((nA ? dmaxA : dmaxB) + 1);
            const bf16* nkb0 = (const bf16*)(kvh + (nA ? KVH_KA : KVH_KB)) + nho - (size_t)(64 * nrot) * 64; const bf16* nvb0 = (const bf16*)(kvh + (nA ? KVH_VA : KVH_VB)) + nho - (size_t)(64 * nrot) * 64;
            f32x16 oa0, oa1, ob0, ob1;
#pragma unroll
            for (int r = 0; r < 16; ++r) { oa0[r] = 0.f; oa1[r] = 0.f; ob0[r] = 0.f; ob1[r] = 0.f; }
            const int rot = ci % (dmax + 1);
            for (int sidx = 0; sidx <= dmax; ++sidx) {
                int dd = sidx + rot; if (dd > dmax) dd -= dmax + 1;
                int ddn = dd + 1; if (ddn > dmax) ddn = 0;
                const bool first = (!isA) && sidx == 0;
                unsigned klu = (unsigned)(__UINTPTR_TYPE__)kl; asm volatile("" : "+s"(klu));
                asm volatile("s_waitcnt vmcnt(8)" ::: "memory");
                f32x16 sA, sB; bf16x8 pA[2], pB[2];
                att_scores2(sA, sB, qf0, qf1, kl + kro, 0, hh, km, tbl, isA, dd, nslope2, cb, base0, first ? 0.f : m2a, first ? 0.f : m2b);
                att_softmax1(sA, oa0, oa1, m2a, la, first, pA); att_softmax1(sB, ob0, ob1, m2b, lb, first, pB);
                asm volatile("s_waitcnt vmcnt(0)" ::: "memory");
                att_pv2(0, pA, pB, oa0, oa1, ob0, ob1, vl, tr0);
                att_scores2(sA, sB, qf0, qf1, kl + kro, 1, hh, km, tbl, isA, dd, nslope2, cb, base0, m2a, m2b);
                __builtin_amdgcn_sched_barrier(0);
                if (sidx < dmax) { const bf16* kp = kb0 - (size_t)(64 * ddn) * 64; ATT_DMAK(kp); }
                else if (it < 3) { ATT_DMAK(nkb0); }
                att_softmax1(sA, oa0, oa1, m2a, la, false, pA); att_softmax1(sB, ob0, ob1, m2b, lb, false, pB);
                att_pv2(1, pA, pB, oa0, oa1, ob0, ob1, vl, tr0);
                __builtin_amdgcn_sched_barrier(0);
                if (sidx < dmax) { const bf16* vp = vb0 - (size_t)(64 * ddn) * 64; ATT_DMAV(vp); }
                else if (it < 3) { ATT_DMAV(nvb0); }
            }
            if (it < 3) {
                const int nh = head + 8; const bf16* qp = qkv + (size_t)(tok0 + l31) * DIN + ((it + 1) < 2 ? COL_QA + nh * 64 : COL_QB + (nh - 16) * 64) + 8 * hh;
#pragma unroll
                for (int ks = 0; ks < 4; ++ks) { qn0[ks] = __builtin_nontemporal_load((const bf16x8*)(qp + 16 * ks)); qn1[ks] = __builtin_nontemporal_load((const bf16x8*)(qp + (size_t)32 * DIN + 16 * ks)); } }
#pragma unroll
            for (int qh = 0; qh < 2; ++qh) {
                f32x16& o0 = qh ? ob0 : oa0; f32x16& o1 = qh ? ob1 : oa1; float l = qh ? lb : la;
                { const auto rr = __builtin_amdgcn_permlane32_swap(__float_as_uint(l), __float_as_uint(l), false, false); l = __uint_as_float(rr[0]) + __uint_as_float(rr[1]); }
                const float inv = 1.0f / l; float ssq = 0.f;
#pragma unroll
                for (int r = 0; r < 16; ++r) { o0[r] *= inv; o1[r] *= inv; ssq += o0[r] * o0[r] + o1[r] * o1[r]; }
                ssq += __shfl_xor(ssq, 32);
                if (hh == 0) ssqp[head * 64 + 32 * qh + l31] = ssq;
                unsigned char* op = O + (size_t)(tok0 + 32 * qh + l31) * DM + head * 64 + 16 * hh;
#pragma unroll
                for (int dt = 0; dt < 2; ++dt) { const f32x16& ov = dt ? o1 : o0; unsigned d[4];
#pragma unroll
                    for (int r4 = 0; r4 < 4; ++r4) d[r4] = cvt4_fp8(ov[4 * r4] * F8_SO, ov[4 * r4 + 1] * F8_SO, ov[4 * r4 + 2] * F8_SO, ov[4 * r4 + 3] * F8_SO);
                    const auto s02 = __builtin_amdgcn_permlane32_swap(d[0], d[2], false, false), s13 = __builtin_amdgcn_permlane32_swap(d[1], d[3], false, false);
                    u32x4 w; w.x = s02[0]; w.y = s02[1]; w.z = s13[0]; w.w = s13[1];
                    *(u32x4*)(op + 32 * dt) = w; }
            }
        }
        __syncthreads();
        if (tid < 128) { const int g = tid >> 6, q = tid & 63; float sacc = 0.f;
#pragma unroll
            for (int h = 0; h < 16; ++h) sacc += ssqp[(16 * g + h) * 64 + q];
            float* SSQ = (float*)(a.ws + WS_SSQ); SSQ[(size_t)(tok0 + q) * 2 + g] = sacc; }
        __syncthreads();
    }
}

constexpr int P5_ROWB = 528;
__device__ __forceinline__ void p5_norm_router(const Ctx& a, LAS unsigned char* lds, int tid, int lane, int wave) {
    const bf16* x1 = (const bf16*)(a.ws + WS_X1); const float* mod = (const float*)(a.ws + WS_MOD); unsigned char* H = a.ws + WS_H;
    const float* aux = (const float*)(a.ws + WS_AUX);
    const bf16* wrhi = (const bf16*)(a.ws + WS_WRT); const bf16* wrlo = wrhi + 48 * 2048;
    unsigned char* rt = a.ws + WS_ROUTE;
    int* tok_e = (int*)(rt + RT_TOKE); float* tok_w = (float*)(rt + RT_TOKW); int* tok_rank = (int*)(rt + RT_RANK); int* cntWG = (int*)(rt + RT_CNT);
    constexpr int TILE_B = 16 * P5_ROWB, WR_B = 48 * P5_ROWB;
    const int pairi = wave >> 1, odd = wave & 1;
    LAS unsigned char* uh = lds + pairi * (2 * TILE_B);
    LAS unsigned char* ul = uh + TILE_B;
    LAS unsigned char* wh = lds + 4 * 2 * TILE_B;
    LAS unsigned char* wl = wh + WR_B;
    LAS float* up = (LAS float*)(lds + 4 * 2 * TILE_B + 2 * WR_B);
    LAS float* sp = up + 64 * 48;
    LAS float* lg = sp + 64;
    LAS float* rsd = lg + 64 * 48;
    static_assert(4 * 2 * TILE_B + 2 * WR_B + (64 * 48 + 64 + 64 * 48 + 64) * 4 <= MISC_OFF, "P5 LDS map");
    const int tr = lane & 15, kq = lane >> 4;
    const int hrow = lane >> 5, hl = lane & 31;
    for (int blk = blockIdx.x; blk < 256; blk += gridDim.x) {
        const int t0 = blk * 64 + pairi * 16, b = blk >> 6;
        const bf16* xw = x1 + (size_t)(t0 + 8 * odd + hrow) * DM + 8 * hl;
        const float* ap = aux + 1024 + b * DM + 8 * hl;
        const float* shp = mod + (size_t)b * 16384 + 6144 + 8 * hl; unsigned char* hwp = H + (size_t)(t0 + 8 * odd + hrow) * DM + 8 * hl;
        const int wrow0 = wave * 6;
        if (tid < 64) {
            const f32x4* pr = (const f32x4*)((const float*)(a.ws + WS_RSS) + (size_t)(blk * 64 + tid) * 64); f32x4 acc4 = pr[0];
#pragma unroll
            for (int i = 1; i < 16; ++i) acc4 = acc4 + pr[i];
            rsd[tid] = __builtin_amdgcn_rsqf(((acc4[0] + acc4[1]) + (acc4[2] + acc4[3])) * (1.0f / DM) + EPS); }
        __syncthreads();
        {
            f32x4 acc[2];
            acc[0] = (f32x4){0.f, 0.f, 0.f, 0.f}; acc[1] = (f32x4){0.f, 0.f, 0.f, 0.f};
            u32x4 xv[4], wv[6];
#pragma unroll
            for (int i = 0; i < 4; ++i) xv[i] = __builtin_nontemporal_load((const u32x4*)(xw + (size_t)(2 * i) * DM));
#pragma unroll
            for (int i = 0; i < 6; ++i) { const int r = 2 * (wrow0 + i) + hrow; wv[i] = *(const u32x4*)((r < 48 ? wrhi + (size_t)r * 2048 : wrlo + (size_t)(r - 48) * 2048) + 8 * hl); }
            for (int c4 = 0; c4 < 8; ++c4) {
                const f32x4 a0 = *(const f32x4*)(ap + 256 * c4), a1 = *(const f32x4*)(ap + 256 * c4 + 4), sh0 = *(const f32x4*)(shp + 256 * c4), sh1 = *(const f32x4*)(shp + 256 * c4 + 4);
                u32x4 xn[4];
                if (c4 < 7) {
#pragma unroll
                    for (int i = 0; i < 4; ++i) xn[i] = __builtin_nontemporal_load((const u32x4*)(xw + (size_t)(2 * i) * DM + 256 * (c4 + 1))); }
                __syncthreads();
#pragma unroll
                for (int i = 0; i < 4; ++i) { const u32x4 v = xv[i]; const int r = 8 * odd + 2 * i + hrow; const float rs = rsd[pairi * 16 + r];
                    const f32x4 f0 = {bf_lo(v.x), bf_hi(v.x), bf_lo(v.y), bf_hi(v.y)}, f1 = {bf_lo(v.z), bf_hi(v.z), bf_lo(v.w), bf_hi(v.w)};
                    const f32x4 u0 = f0 * a0, u1 = f1 * a1; u32x4 hi, lo;
                    { const f32x4 h0 = (u0 * rs + sh0) * F8_SH, h1 = (u1 * rs + sh1) * F8_SH; u32x2 hw; hw.x = cvt4_fp8(h0[0], h0[1], h0[2], h0[3]); hw.y = cvt4_fp8(h1[0], h1[1], h1[2], h1[3]);
                      *(u32x2*)(hwp + (size_t)(2 * i) * DM + 256 * c4) = hw; }
                    hi.x = cvtpk(u0[0], u0[1]); hi.y = cvtpk(u0[2], u0[3]); hi.z = cvtpk(u1[0], u1[1]); hi.w = cvtpk(u1[2], u1[3]);
                    lo.x = cvtpk(u0[0] - bf_lo(hi.x), u0[1] - bf_hi(hi.x)); lo.y = cvtpk(u0[2] - bf_lo(hi.y), u0[3] - bf_hi(hi.y));
                    lo.z = cvtpk(u1[0] - bf_lo(hi.z), u1[1] - bf_hi(hi.z)); lo.w = cvtpk(u1[2] - bf_lo(hi.w), u1[3] - bf_hi(hi.w));
                    *(LAS u32x4*)(uh + r * P5_ROWB + 16 * hl) = hi; *(LAS u32x4*)(ul + r * P5_ROWB + 16 * hl) = lo; }
#pragma unroll
                for (int i = 0; i < 6; ++i) { const int r = 2 * (wrow0 + i) + hrow; *(LAS u32x4*)(wh + r * P5_ROWB + 16 * hl) = wv[i]; }
                if (c4 < 7) {
#pragma unroll
                    for (int i = 0; i < 6; ++i) { const int r = 2 * (wrow0 + i) + hrow; wv[i] = *(const u32x4*)((r < 48 ? wrhi + (size_t)r * 2048 : wrlo + (size_t)(r - 48) * 2048) + 256 * (c4 + 1) + 8 * hl); } }
                __syncthreads();
#pragma unroll 2
                for (int kk = 0; kk < 8; ++kk) {
                    const bf16x8 ahi = *(const LAS bf16x8*)(uh + tr * P5_ROWB + 64 * kk + 16 * kq), alo = *(const LAS bf16x8*)(ul + tr * P5_ROWB + 64 * kk + 16 * kq);
                    if (!odd) {
#pragma unroll
                        for (int c = 0; c < 2; ++c) { const bf16x8 bhi = *(const LAS bf16x8*)(wh + (16 * c + tr) * P5_ROWB + 64 * kk + 16 * kq), blo = *(const LAS bf16x8*)(wl + (16 * c + tr) * P5_ROWB + 64 * kk + 16 * kq);
                            acc[c] = __builtin_amdgcn_mfma_f32_16x16x32_bf16(ahi, bhi, acc[c], 0, 0, 0);
                            acc[c] = __builtin_amdgcn_mfma_f32_16x16x32_bf16(ahi, blo, acc[c], 0, 0, 0);
                            acc[c] = __builtin_amdgcn_mfma_f32_16x16x32_bf16(alo, bhi, acc[c], 0, 0, 0); }
                    } else { const bf16x8 bhi = *(const LAS bf16x8*)(wh + (32 + tr) * P5_ROWB + 64 * kk + 16 * kq), blo = *(const LAS bf16x8*)(wl + (32 + tr) * P5_ROWB + 64 * kk + 16 * kq);
                        acc[0] = __builtin_amdgcn_mfma_f32_16x16x32_bf16(ahi, bhi, acc[0], 0, 0, 0);
                        acc[0] = __builtin_amdgcn_mfma_f32_16x16x32_bf16(ahi, blo, acc[0], 0, 0, 0);
                        acc[0] = __builtin_amdgcn_mfma_f32_16x16x32_bf16(alo, bhi, acc[0], 0, 0, 0); }
                }
                if (c4 < 7) {
#pragma unroll
                    for (int i = 0; i < 4; ++i) xv[i] = xn[i]; }
            }
            if (!odd) {
#pragma unroll
                for (int c = 0; c < 2; ++c)
#pragma unroll
                    for (int r = 0; r < 4; ++r) up[(pairi * 16 + 4 * kq + r) * 48 + 16 * c + tr] = acc[c][r];
            } else {
#pragma unroll
                for (int r = 0; r < 4; ++r) up[(pairi * 16 + 4 * kq + r) * 48 + 32 + tr] = acc[0][r];
            }
        }
        __syncthreads();
        for (int i = tid; i < 64 * 48; i += 512) { const int tok = i / 48, c = i - tok * 48; lg[i] = rsd[tok] * up[i] + aux[b * 48 + c]; }
        __syncthreads();
        if (tid < 64) {
            const int tt = blk * 64 + tid; const LAS float* L = lg + tid * 48;
            float gl[4]; int gi = 0;
#pragma unroll
            for (int j = 0; j < 4; ++j) gl[j] = L[j];
            float gm = gl[0];
#pragma unroll
            for (int j = 1; j < 4; ++j) if (gl[j] > gm) { gm = gl[j]; gi = j; }
            float den = 0.f;
#pragma unroll
            for (int j = 0; j < 4; ++j) den += __expf(gl[j] - gm);
            const float pg = 1.0f / den;
            float el[8];
#pragma unroll
            for (int i = 0; i < 8; ++i) el[i] = L[4 + 8 * gi + i];
            int i1 = 0; float v1 = el[0];
#pragma unroll
            for (int i = 1; i < 8; ++i) if (el[i] > v1) { v1 = el[i]; i1 = i; }
            int i2 = -1; float v2 = -3.0e38f;
#pragma unroll
            for (int i = 0; i < 8; ++i) if (i != i1 && el[i] > v2) { v2 = el[i]; i2 = i; }
            const float ex = __expf(v2 - v1), w1 = pg / (1.0f + ex), w2 = pg * ex / (1.0f + ex);
            const int e1 = gi * 8 + i1, e2 = gi * 8 + i2;
            const unsigned long long lt = (1ull << lane) - 1ull;
            int r1 = 0, r2 = 0, mycnt = 0;
            for (int e = 0; e < NEXP; ++e) { const unsigned long long m1 = __ballot(e1 == e), m2 = __ballot(e2 == e); const int c1 = __popcll(m1);
                if (e1 == e) r1 = __popcll(m1 & lt); if (e2 == e) r2 = c1 + __popcll(m2 & lt); if (lane == e) mycnt = c1 + __popcll(m2); }
            tok_e[2 * tt] = e1; tok_e[2 * tt + 1] = e2; tok_w[2 * tt] = w1; tok_w[2 * tt + 1] = w2; tok_rank[2 * tt] = r1; tok_rank[2 * tt + 1] = r2;
            if (lane < NEXP) cntWG[blk * NEXP + lane] = mycnt;
        }
        __syncthreads();
    }
}

constexpr int P6_TS_OFF = 138240;
__device__ __forceinline__ void p6_slots(const Ctx& a, LAS unsigned char* lds, int tid) {
    unsigned char* rt = a.ws + WS_ROUTE;
    const int* tok_e = (const int*)(rt + RT_TOKE); const int* tok_rank = (const int*)(rt + RT_RANK); int* tok_slot = (int*)(rt + RT_SLOT); const int* cntWG = (const int*)(rt + RT_CNT);
    int* rowidx = (int*)(rt + RT_ROWIDX); int* tile_exp = (int*)(rt + RT_TILEEXP); int* ntiles = (int*)(rt + RT_NTILES);
    LAS int* ptot = (LAS int*)lds;
    LAS int* ppre = ptot + 512;
    LAS int* tot = ppre + 512;
    LAS int* pre = tot + 32;
    LAS int* sb = pre + 32;
    for (int blk = blockIdx.x; blk < 256; blk += gridDim.x) {
        { const int e = tid & 31, part = tid >> 5; int st = 0, sp = 0;
            for (int w = part * 16; w < part * 16 + 16; ++w) { const int c = cntWG[w * NEXP + e]; st += c; if (w < blk) sp += c; }
            ptot[part * 32 + e] = st; ppre[part * 32 + e] = sp; }
        __syncthreads();
        if (tid < 32) { int st = 0, sp = 0;
#pragma unroll
            for (int p = 0; p < 16; ++p) { st += ptot[p * 32 + tid]; sp += ppre[p * 32 + tid]; }
            tot[tid] = st; pre[tid] = sp; }
        __syncthreads();
        if (tid == 0) { int s = 0; for (int e = 0; e < NEXP; ++e) { sb[e] = s; s += ((tot[e] + 255) >> 8) << 8; } sb[NEXP] = s; }
        __syncthreads();
        if (tid < 128) { const int tk = blk * 64 + (tid >> 1), j = tid & 1; const int e = tok_e[2 * tk + j]; const int slot = sb[e] + pre[e] + tok_rank[2 * tk + j];
            tok_slot[2 * tk + j] = slot; rowidx[slot] = tk; }
        if (blk < NEXP) { const int e = blk, s0 = sb[e] + tot[e], s1 = sb[e + 1];
            for (int s = s0 + tid; s < s1; s += 512) rowidx[s] = 0;
            for (int g = (sb[e] >> 8) + tid; g < (sb[e + 1] >> 8); g += 512) tile_exp[g] = e; }
        if (blk == 0 && tid == 0) ntiles[0] = sb[NEXP] >> 8;
        if (blk == 0 && tid <= NEXP) ((int*)(rt + RT_TSTART))[tid] = sb[tid] >> 8;
        if (tid <= NEXP) ((LAS int*)(lds + P6_TS_OFF))[tid] = sb[tid] >> 8;
        __syncthreads();
    }
}

__device__ __forceinline__ void p9_final(const Ctx& a, int lane, int wave) {
    const bf16* X = (const bf16*)(a.ws + WS_X1); float* OUT = a.out; const float* gf = a.in[I_GFIN]; const float* mod = (const float*)(a.ws + WS_MOD); const unsigned char* Y = a.ws + WS_Y;
    unsigned char* rt = a.ws + WS_ROUTE; const int* tok_slot = (const int*)(rt + RT_SLOT); const float* tok_w = (const float*)(rt + RT_TOKW);
    const int gw = blockIdx.x * 8 + wave, NGW = gridDim.x * 8;
    for (int grp = gw; grp < NT / 8; grp += NGW) {
        const int row0 = grp * 8, b = row0 >> 12;
        f32x4 A[8], Bv[8], G2[8];
#pragma unroll
        for (int j = 0; j < 8; ++j) { const int k = 4 * lane + 256 * j; const f32x4 gg = *(const f32x4*)(gf + k), sc = *(const f32x4*)(mod + (size_t)b * 16384 + 12288 + 2048 + k);
            A[j] = gg * (1.0f + sc); Bv[j] = *(const f32x4*)(mod + (size_t)b * 16384 + 12288 + k); G2[j] = *(const f32x4*)(mod + (size_t)b * 16384 + 10240 + k); }
        const int lr = lane & 7; const int2 sl = *(const int2*)(tok_slot + 2 * (row0 + lr)); const f32x2_t wl = *(const f32x2_t*)(tok_w + 2 * (row0 + lr));
        for (int r = 0; r < 8; r += 2) {
            u32x2 xb[2][8]; unsigned ya[2][8], yb[2][8]; float w1[2], w2[2];
#pragma unroll
            for (int h = 0; h < 2; ++h) { const int t = row0 + r + h;
                const int s1 = __builtin_amdgcn_readlane(sl.x, r + h), s2 = __builtin_amdgcn_readlane(sl.y, r + h);
                w1[h] = __uint_as_float(__builtin_amdgcn_readlane(__float_as_uint(wl.x), r + h)) * (1.0f / F8_SY); w2[h] = __uint_as_float(__builtin_amdgcn_readlane(__float_as_uint(wl.y), r + h)) * (1.0f / F8_SY);
                const bf16* xr = X + (size_t)t * DM + 4 * lane; const unsigned char* y1 = Y + (size_t)s1 * DM + 4 * lane; const unsigned char* y2 = Y + (size_t)s2 * DM + 4 * lane;
#pragma unroll
                for (int j = 0; j < 8; ++j) { xb[h][j] = __builtin_nontemporal_load((const u32x2*)(xr + 256 * j)); ya[h][j] = __builtin_nontemporal_load((const unsigned*)(y1 + 256 * j)); yb[h][j] = __builtin_nontemporal_load((const unsigned*)(y2 + 256 * j)); } }
#pragma unroll
            for (int h = 0; h < 2; ++h) { float* outr = OUT + (size_t)(row0 + r + h) * DM + 4 * lane; f32x4 v[8]; float s = 0.f;
#pragma unroll
                for (int j = 0; j < 8; ++j) { const u32x2 x2 = xb[h][j]; const f32x4 xv = {bf_lo(x2.x), bf_hi(x2.x), bf_lo(x2.y), bf_hi(x2.y)};
                    const f32x2_t p0 = __builtin_amdgcn_cvt_pk_f32_fp8((int)ya[h][j], false), p1 = __builtin_amdgcn_cvt_pk_f32_fp8((int)ya[h][j], true), q0 = __builtin_amdgcn_cvt_pk_f32_fp8((int)yb[h][j], false), q1 = __builtin_amdgcn_cvt_pk_f32_fp8((int)yb[h][j], true);
                    f32x4 yv; yv[0] = w1[h] * p0[0] + w2[h] * q0[0]; yv[1] = w1[h] * p0[1] + w2[h] * q0[1]; yv[2] = w1[h] * p1[0] + w2[h] * q1[0]; yv[3] = w1[h] * p1[1] + w2[h] * q1[1];
                    v[j] = xv + G2[j] * yv; s += (v[j][0] * v[j][0] + v[j][1] * v[j][1]) + (v[j][2] * v[j][2] + v[j][3] * v[j][3]); }
                const float rstd = __builtin_amdgcn_rsqf(wave_sum(s) * (1.0f / DM) + EPS);
#pragma unroll
                for (int j = 0; j < 8; ++j) __builtin_nontemporal_store(v[j] * rstd * A[j] + Bv[j], (f32x4*)(outr + 256 * j)); }
        }
    }
}

constexpr int NPH = 10;
constexpr int SEAM_ND = 9 * 256;
constexpr int SEAM_NG = CV_G_P4L - (CV_IN + CV_OUT), SEAM_NU = CV_UP_TAIL - CV_UP0, SEAM_ITEMS = SEAM_NG + SEAM_NU + SEAM_ND;
static_assert(SEAM_ITEMS <= 27 * 256, "seam conversion capacity");
__device__ __forceinline__ void seam_convert(const Ctx& args, LAS unsigned char* lds, int lane, int wave, int seam) {
    const int per = 5 + (seam & 1), base = 256 * (5 * seam + (seam >> 1) + 0) + 256 * 0;
    if (gridDim.x != 256 || wave < 1 || wave > per) return;
    const int t = base + (int)blockIdx.x * per + (wave - 1);
    if (t >= SEAM_ITEMS) return;
    const int it = t < SEAM_NG ? (CV_IN + CV_OUT) + t : (t < SEAM_NG + SEAM_NU ? CV_UP0 + (t - SEAM_NG) : (CV_ALL - SEAM_ND) + (t - SEAM_NG - SEAM_NU));
    convert_items(args, lds, lane, wave, it, it + 1, 0, 1);
}
__device__ __forceinline__ void p7_convert(const Ctx& args, LAS unsigned char* lds, int lane, int wave, const int* ts) {
    { const int G = (int)gridDim.x;
          const int nlab = (G % 8 == 0) ? 8 : 1, Gx = G / nlab, myx = nlab == 8 ? ((int)blockIdx.x & 7) : 0, myj = nlab == 8 ? ((int)blockIdx.x >> 3) : (int)blockIdx.x;
          int maxload = 0;
          for (int x = 0; x < nlab; ++x) { int nu, fullr, R, split; pg8::GroupedOrder::label_shape(ts, 4, x, nlab, Gx, nu, fullr, R, split);
              const int top = 2 * fullr + (R > 0 ? (split ? 1 : 2) : 0); maxload = top > maxload ? top : maxload; }
          int nconv = 0, myidx = -1;
          for (int x = 0; x < nlab; ++x) { int nu, fullr, R, split; pg8::GroupedOrder::label_shape(ts, 4, x, nlab, Gx, nu, fullr, R, split);
              const int a = R > 0 ? (split ? 2 * R : R) : 0, top = 2 * fullr + (R > 0 ? (split ? 1 : 2) : 0);
              const int nfull = (a > 0 && top == maxload) ? a : ((2 * fullr == maxload) ? Gx : 0);
              if (x == myx && myj >= nfull) myidx = nconv + (myj - nfull);
              nconv += Gx - nfull; }
          if (nconv == 0) convert_items(args, lds, lane, wave, CV_DN_TAIL, CV_ALL - (G == 256 ? SEAM_ND : 0), (int)blockIdx.x * 8 + wave, G * 8);
          else if (myidx >= 0) convert_items(args, lds, lane, wave, CV_DN_TAIL, CV_ALL - (G == 256 ? SEAM_ND : 0), myidx * 8 + wave, nconv * 8);
    }
}
__global__ void __launch_bounds__(512, 2) hybrid_fwd(Args kargs) {
    extern __shared__ __attribute__((aligned(16))) unsigned char lds_raw[];
    LAS unsigned char* lds = (LAS unsigned char*)lds_raw;
    const int tid = threadIdx.x, lane = tid & 63, wave = __builtin_amdgcn_readfirstlane(tid >> 6);
    volatile LAS unsigned* MISC = (volatile LAS unsigned*)(lds + MISC_OFF);
    if (tid < 4) MISC[tid] = 0u;
    __syncthreads();
    const int lo = kargs.ph_lo, hi = kargs.ph_hi;
    Ctx args; args.out = kargs.out; args.ws = kargs.ws;
    XcdBarrier bar; bar.bar = (unsigned*)(args.ws + WS_CTL); bar.x = 0; bar.st = nullptr;
    if (hi - lo > 1) bar = xcd_barrier_post((unsigned*)(args.ws + WS_CTL), MISC);
#define IN(k) (lo <= (k) && (k) < hi)
#define REPS(k) (((REPEAT_MASK >> (k)) & 1) ? 2 : 1)
#define SEAM(k) do { if (IN(k) && IN((k) + 1)) xcd_barrier(bar); } while (0)

    if (IN(0)) for (int rep = 0; rep < REPS(0); ++rep) { p0_mod(args, lds, tid, lane, wave); p0_convert(args, lds, tid, lane, wave); __syncthreads(); }
    if (IN(0) && IN(1)) mod_wait(args, tid);
    if (IN(1)) for (int rep = 0; rep < REPS(1); ++rep) { p1_norm(args, lane, wave); }
    if (IN(1) && IN(2)) { const XcdTicket tk1 = xcd_barrier_arrive(bar); seam_convert(args, lds, lane, wave, 0); xcd_barrier_wait(bar, tk1); }
    if (IN(2)) for (int rep = 0; rep < REPS(2); ++rep) {
        pg8::DenseOrder S; S.init(args.ws + WS_H, args.ws + WS_WIN, NT, DIN, DM, (int)gridDim.x, (int)blockIdx.x);
        pg8::EpiQKV E{(bf16*)(args.ws + WS_QKV), (bf16*)(args.ws + WS_KVH)};
        { const int G = (int)gridDim.x, rem = S.nwg % G;
          if (rem != 0 && (int)blockIdx.x >= rem) convert_items(args, lds, lane, wave, CV_UP_TAIL, CV_DN0, ((int)blockIdx.x - rem) * 8 + wave, (G - rem) * 8);
          else if (rem == 0) convert_items(args, lds, lane, wave, CV_UP_TAIL, CV_DN0, (int)blockIdx.x * 8 + wave, G * 8);
          __syncthreads(); }
        pg8::gemm_phase<pg8::EpiQKV, pg8::DenseOrder, false>(lds, DM, S, E);
    }
    if (IN(2) && IN(3)) { const XcdTicket tk2 = xcd_barrier_arrive(bar); seam_convert(args, lds, lane, wave, 1); xcd_barrier_wait(bar, tk2); }
    if (IN(3)) for (int rep = 0; rep < REPS(3); ++rep) { p3_attn(args, lds, tid, lane, wave); }
    if (IN(3) && IN(4)) { const XcdTicket tk3 = xcd_barrier_arrive(bar); seam_convert(args, lds, lane, wave, 2); xcd_barrier_wait(bar, tk3); }
    if (IN(4)) for (int rep = 0; rep < REPS(4); ++rep) {
        pg8::DenseOrder S; S.init(args.ws + WS_O, args.ws + WS_WOUT, NT, DM, DM / 2, (int)gridDim.x, (int)blockIdx.x);
        pg8::EpiRes E{args.in[I_X], (bf16*)(args.ws + WS_X1), (const float*)(args.ws + WS_MOD), (const float*)(args.ws + WS_SSQ), (float*)(args.ws + WS_RSS)};
        { const int G = (int)gridDim.x; if ((int)blockIdx.x >= G / 2) convert_items(args, lds, lane, wave, CV_G_P4, CV_UP0, ((int)blockIdx.x - G / 2) * 8 + wave, (G - G / 2) * 8); __syncthreads(); }
        {
            LAS float* tab = (LAS float*)(lds + pg8::EpiRes::TAB_OFF); const float* SSQ = (const float*)(args.ws + WS_SSQ); pg8::Unit u;
            for (int i = 0; i < 8 && S.next(i, u); ++i)
                if (tid < 256) { const float qa = SSQ[(size_t)(u.pm * 256 + tid) * 2], qb = SSQ[(size_t)(u.pm * 256 + tid) * 2 + 1];
                    const float rA = __builtin_amdgcn_rsqf(qa * (1.0f / 1024.0f) + EPS), rB = __builtin_amdgcn_rsqf(qb * (1.0f / 1024.0f) + EPS);
                    tab[(i * 256 + tid) * 2] = rA / rB; tab[(i * 256 + tid) * 2 + 1] = rB * (1.0f / (F8_SO * F8_SWO)); }
            __syncthreads();
        }
        pg8::gemm_phase<pg8::EpiRes, pg8::DenseOrder, false, true>(lds, DM / 2, S, E);
        { const int G = (int)gridDim.x; if ((int)blockIdx.x < G / 2) { __syncthreads(); int t2 = threadIdx.x; asm volatile("" : "+v"(t2)); const int l2 = t2 & 63, w2 = __builtin_amdgcn_readfirstlane(t2 >> 6);
            convert_items(args, lds, l2, w2, CV_G_P4L, CV_G_P4, (int)blockIdx.x * 8 + w2, (G / 2) * 8); } }
    }
    if (IN(4) && IN(5)) { const XcdTicket tk4 = xcd_barrier_arrive(bar); seam_convert(args, lds, lane, wave, 3); xcd_barrier_wait(bar, tk4); }
    if (IN(5)) for (int rep = 0; rep < REPS(5); ++rep) { p5_norm_router(args, lds, tid, lane, wave); }
    if (IN(5) && IN(6)) { const XcdTicket tk5 = xcd_barrier_arrive(bar); seam_convert(args, lds, lane, wave, 4); xcd_barrier_wait(bar, tk5); }
    if (IN(6)) { p6_slots(args, lds, tid); }
    bool p7_conv_done = false;
    if (IN(6) && IN(7)) {
        const XcdTicket tk = xcd_barrier_arrive(bar);
        p7_convert(args, lds, lane, wave, (const int*)((LAS int*)(lds + P6_TS_OFF))); p7_conv_done = true;
        xcd_barrier_wait(bar, tk);
    }
    if (IN(7)) for (int rep = 0; rep < REPS(7); ++rep) {
        unsigned char* rt = args.ws + WS_ROUTE;
        pg8::GroupedOrder S; S.A = (const char*)(args.ws + WS_H); S.Bt = (const char*)(args.ws + WS_WGU); S.estride = (size_t)1024 * DM; S.K = DM / 2;
        S.rowidx = (const int*)(rt + RT_ROWIDX);
        const int ntiles = *(const int*)(rt + RT_NTILES);
        pg8::EpiGU E{args.ws + WS_ACT};
        { if (!p7_conv_done) p7_convert(args, lds, lane, wave, (const int*)(rt + RT_TSTART));
          __syncthreads(); }
        S.build(lds, (const int*)(rt + RT_TSTART), 4, (int)gridDim.x, (int)blockIdx.x);
        pg8::gemm_phase<pg8::EpiGU, pg8::GroupedOrder, true, true>(lds, DM / 2, S, E);
    }
    SEAM(7);
    if (IN(8)) for (int rep = 0; rep < REPS(8); ++rep) {
        unsigned char* rt = args.ws + WS_ROUTE;
        pg8::GroupedOrder S; S.A = (const char*)(args.ws + WS_ACT); S.Bt = (const char*)(args.ws + WS_WD); S.estride = (size_t)DM * DE; S.K = DE / 2;
        S.rowidx = nullptr; S.build(lds, (const int*)(rt + RT_TSTART), 8, (int)gridDim.x, (int)blockIdx.x);
        pg8::EpiY E{args.ws + WS_Y};
        pg8::gemm_phase<pg8::EpiY, pg8::GroupedOrder, false, true>(lds, DE / 2, S, E);
    }
    SEAM(8);
    if (IN(9)) { p9_final(args, lane, wave); }
#undef IN
#undef SEAM
}

extern "C" void kernel_launch(void* const* d_in, const int* in_sizes, int n_in, void* d_out, int out_size, void* d_ws, size_t ws_size, hipStream_t stream) {
    static int grid = 0;
    if (grid == 0) {
        if (n_in != 22 || out_size != NT * DM || ws_size < WS_END) { fprintf(stderr, "kernel_launch: unexpected shapes (n_in %d, out %d, ws %zu)\n", n_in, out_size, ws_size); grid = -1; return; }
        int dev = 0, cus = 0, per_cu = 0;
        if (hipGetDevice(&dev) != hipSuccess || hipDeviceGetAttribute(&cus, hipDeviceAttributeMultiprocessorCount, dev) != hipSuccess) { grid = -1; return; }
        if (hipFuncSetAttribute((const void*)hybrid_fwd, hipFuncAttributeMaxDynamicSharedMemorySize, LDS_BYTES) != hipSuccess) { fprintf(stderr, "kernel_launch: hipFuncSetAttribute failed\n"); grid = -1; return; }
        if (hipOccupancyMaxActiveBlocksPerMultiprocessor(&per_cu, (const void*)hybrid_fwd, 512, LDS_BYTES) != hipSuccess || per_cu < 1) { fprintf(stderr, "kernel_launch: occupancy query says %d\n", per_cu); }
        (void)hipGetLastError();
        grid = cus;
    }
    if (grid < 0) return;
    (void)hipMemsetAsync((char*)d_ws + WS_CTL, 0, CTL_ZERO_BYTES, stream);
    Args a{};
    for (int i = 0; i < 22; ++i) a.in[i] = (const float*)d_in[i];
    a.out = (float*)d_out; a.ws = (unsigned char*)d_ws;
#if MK_PER_PHASE
    for (int p = 0; p < NPH; ++p) { a.ph_lo = p; a.ph_hi = p + 1; hipLaunchKernelGGL(hybrid_fwd, dim3(grid), dim3(512), LDS_BYTES, stream, a); }
#else
    if (PROBE_EXTRA_PHASE >= 0) {
        a.ph_lo = 0; a.ph_hi = PROBE_EXTRA_PHASE + 1; hipLaunchKernelGGL(hybrid_fwd, dim3(grid), dim3(512), LDS_BYTES, stream, a);
        (void)hipMemsetAsync((char*)d_ws + WS_CTL, 0, CTL_ZERO_BYTES, stream);
        a.ph_lo = PROBE_EXTRA_PHASE; a.ph_hi = PROBE_EXTRA_PHASE + 1; hipLaunchKernelGGL(hybrid_fwd, dim3(grid), dim3(512), LDS_BYTES, stream, a);
        if (PROBE_EXTRA_PHASE + 1 < NPH) { a.ph_lo = PROBE_EXTRA_PHASE + 1; a.ph_hi = NPH; hipLaunchKernelGGL(hybrid_fwd, dim3(grid), dim3(512), LDS_BYTES, stream, a); }
    } else { a.ph_lo = 0; a.ph_hi = NPH; hipLaunchKernelGGL(hybrid_fwd, dim3(grid), dim3(512), LDS_BYTES, stream, a); }
#endif
}
```
